# Optimizing an MI355X kernel written in HIP

```python
import math
import jax, jax.numpy as jnp
from jax import lax
import numpy as np

D_MODEL = 2048
BATCH = 1
SEQ = 8192
DEPTH = 2

MIX_WIDTH = D_MODEL
GW = MIX_WIDTH // 4
GDN_HEAD_DIM = 128
GDN_HEADS = GW // GDN_HEAD_DIM
GDN_CONV = 4
GDN_CHUNK = 64
SSM_HEAD_DIM = 64
SSM_HEADS = GW // SSM_HEAD_DIM
SSM_GROUPS = 2
SSM_STATE = 128
SSM_CONV = 4
SSM_CHUNK = 128
SSM_CONV_DIM = GW + 2 * SSM_GROUPS * SSM_STATE
ATTN_HEAD_DIM = 64
ATTN_Q_HEADS = GW // ATTN_HEAD_DIM
ATTN_KV_HEADS = ATTN_Q_HEADS // 4
WINDOW = 128
ROPE_THETA = 10000.0
SC_CONV = 3
SC_GROUPS = 4
MLP_HIDDEN = 4 * D_MODEL
EPS = 1e-6

IN_WIDTH = (4 * GW + 2 * GDN_HEADS) + (GW + SSM_CONV_DIM + SSM_HEADS) + (GW + 2 * ATTN_KV_HEADS * ATTN_HEAD_DIM) + 3 * GW

kernel_name = 'hymba_style_hybrid_gdn_ssd_swa_shortconv'


def in_proj_split_points():
    sizes = (GW, GW, GW, GW, GDN_HEADS, GDN_HEADS,
             GW, SSM_CONV_DIM, SSM_HEADS,
             GW, ATTN_KV_HEADS * ATTN_HEAD_DIM, ATTN_KV_HEADS * ATTN_HEAD_DIM,
             GW, GW, GW)
    return [int(s) for s in np.cumsum(sizes)[:-1]]


def rms_norm(x, w):
    xf = x.astype(jnp.float32)
    y = xf * lax.rsqrt(jnp.mean(xf * xf, axis=-1, keepdims=True) + EPS)
    return (y * w.astype(jnp.float32)).astype(x.dtype)


def l2_norm(x):
    return x * lax.rsqrt(jnp.sum(x * x, axis=-1, keepdims=True) + EPS)


def causal_dwconv(x, w):
    K, C = w.shape
    return lax.conv_general_dilated(x, w[:, None, :].astype(x.dtype), window_strides=(1,),
                                    padding=[(K - 1, 0)], dimension_numbers=('NWC', 'WIO', 'NWC'),
                                    feature_group_count=C)


def rope_tables(positions):
    inv_freq = ROPE_THETA ** (-jnp.arange(0, ATTN_HEAD_DIM, 2, dtype=jnp.float32) / ATTN_HEAD_DIM)
    ang = positions.astype(jnp.float32)[..., None] * inv_freq
    return jnp.cos(ang), jnp.sin(ang)


def apply_rope(x, cos, sin):
    x1, x2 = jnp.split(x, 2, axis=-1)
    return jnp.concatenate([x1 * cos - x2 * sin, x2 * cos + x1 * sin], axis=-1).astype(x.dtype)


def gated_deltanet(q, k, v, z, b, a, conv_w, a_log, dt_bias, norm_w):
    Bsz, L, _ = q.shape
    H, dk, Cs = GDN_HEADS, GDN_HEAD_DIM, GDN_CHUNK
    Nc = L // Cs
    f32 = jnp.float32
    qkv = jax.nn.silu(causal_dwconv(jnp.concatenate([q, k, v], axis=-1), conv_w))
    q, k, v = [t.reshape(Bsz, L, H, dk).astype(f32) for t in jnp.split(qkv, 3, axis=-1)]
    q = l2_norm(q) * (dk ** -0.5)
    k = l2_norm(k)
    beta = jax.nn.sigmoid(b.astype(f32))
    g = -jnp.exp(a_log.astype(f32)) * jax.nn.softplus(a.astype(f32) + dt_bias.astype(f32))

    def to_chunks(t):
        return t.reshape(Bsz, Nc, Cs, H, -1).transpose(0, 3, 1, 2, 4)

    q, k, v = to_chunks(q), to_chunks(k), to_chunks(v)
    beta = to_chunks(beta[..., None])[..., 0]
    gc = jnp.cumsum(to_chunks(g[..., None])[..., 0], axis=-1)
    tri_incl = jnp.tril(jnp.ones((Cs, Cs), dtype=bool))
    tri_strict = jnp.tril(jnp.ones((Cs, Cs), dtype=bool), -1)
    decay = jnp.exp(jnp.where(tri_incl, gc[..., :, None] - gc[..., None, :], -jnp.inf))
    k_beta = k * beta[..., None]
    m = jnp.where(tri_strict, jnp.einsum('bhncd,bhnsd->bhncs', k_beta, k) * decay, 0.0)
    eye = jnp.eye(Cs, dtype=f32)
    t_inv = lax.linalg.triangular_solve(eye + m, jnp.broadcast_to(eye, m.shape), left_side=True,
                                        lower=True, unit_diagonal=True)
    u = t_inv @ (v * beta[..., None])
    w = t_inv @ (k_beta * jnp.exp(gc)[..., None])
    attn = jnp.where(tri_incl, jnp.einsum('bhncd,bhnsd->bhncs', q, k) * decay, 0.0)
    q_dec = q * jnp.exp(gc)[..., None]
    k_dec = k * jnp.exp(gc[..., -1:] - gc)[..., None]
    chunk_dec = jnp.exp(gc[..., -1])

    def step(S, inp):
        u_c, w_c, qd_c, kd_c, at_c, cd_c = inp
        v_new = u_c - w_c @ S
        o = qd_c @ S + at_c @ v_new
        S = S * cd_c[..., None, None] + jnp.swapaxes(kd_c, -1, -2) @ v_new
        return S, o

    xs = tuple(jnp.moveaxis(t, 2, 0) for t in (u, w, q_dec, k_dec, attn, chunk_dec))
    _, o = lax.scan(step, jnp.zeros((Bsz, H, dk, dk), f32), xs)
    o = o.transpose(1, 0, 3, 2, 4).reshape(Bsz, L, H, dk)
    zf = z.reshape(Bsz, L, H, dk).astype(f32)
    o = rms_norm(o, norm_w) * jax.nn.silu(zf)
    return o.reshape(Bsz, L, GW).astype(z.dtype)


def mamba2_ssd(z, xbc, dt, conv_w, conv_b, a_log, dt_bias, d_skip, norm_w):
    Bsz, L, _ = z.shape
    G, R, P, N, Cs = SSM_GROUPS, SSM_HEADS // SSM_GROUPS, SSM_HEAD_DIM, SSM_STATE, SSM_CHUNK
    Nc = L // Cs
    f32 = jnp.float32
    xbc = jax.nn.silu(causal_dwconv(xbc, conv_w) + conv_b)
    xs, bm, cm = jnp.split(xbc.astype(f32), [GW, GW + G * N], axis=-1)
    xs = xs.reshape(Bsz, Nc, Cs, G, R, P)
    bm = bm.reshape(Bsz, Nc, Cs, G, N)
    cm = cm.reshape(Bsz, Nc, Cs, G, N)
    dt = jax.nn.softplus(dt.astype(f32) + dt_bias.astype(f32)).reshape(Bsz, Nc, Cs, G, R)
    a = -jnp.exp(a_log.astype(f32)).reshape(G, R)
    da_cs = jnp.cumsum((dt * a).transpose(0, 3, 4, 1, 2), axis=-1)
    tri = jnp.tril(jnp.ones((Cs, Cs), dtype=bool))
    lmat = jnp.exp(jnp.where(tri, da_cs[..., :, None] - da_cs[..., None, :], -jnp.inf))
    xdt = xs * dt[..., None]
    cb = jnp.einsum('bclgn,bcsgn->bgcls', cm, bm)
    y_diag = jnp.einsum('bgcls,bgrcls,bcsgrp->bclgrp', cb, lmat, xdt)
    decay_states = jnp.exp(da_cs[..., -1:] - da_cs)
    states = jnp.einsum('bclgn,bgrcl,bclgrp->bcgrpn', bm, decay_states, xdt)
    chunk_dec = jnp.exp(da_cs[..., -1])

    def step(S, inp):
        st, dec = inp
        return S * dec[..., None, None] + st, S

    _, prev = lax.scan(step, jnp.zeros((Bsz, G, R, P, N), f32),
                       (jnp.moveaxis(states, 1, 0), jnp.moveaxis(chunk_dec, 3, 0)))
    prev = jnp.moveaxis(prev, 0, 1)
    y_off = jnp.einsum('bclgn,bcgrpn,bgrcl->bclgrp', cm, prev, jnp.exp(da_cs))
    y = y_diag + y_off + xs * d_skip.astype(f32).reshape(G, R)[:, :, None]
    y = y.reshape(Bsz, L, GW) * jax.nn.silu(z.astype(f32))
    y = rms_norm(y.reshape(Bsz, L, G, GW // G), norm_w.reshape(G, GW // G))
    return y.reshape(Bsz, L, GW).astype(z.dtype)


def band_blocks(t):
    Bsz, L = t.shape[:2]
    cur = t.reshape(Bsz, L // WINDOW, WINDOW, *t.shape[2:])
    prev = jnp.pad(cur[:, :-1], ((0, 0), (1, 0), (0, 0), (0, 0), (0, 0)))
    return jnp.concatenate([prev, cur], axis=2)


def sliding_window_attention(q, k, v, sinks, cos, sin):
    Bsz, L, _ = q.shape
    Hkv, R, hd, W = ATTN_KV_HEADS, ATTN_Q_HEADS // ATTN_KV_HEADS, ATTN_HEAD_DIM, WINDOW
    nb = L // W
    q = apply_rope(q.reshape(Bsz, L, Hkv, R, hd), cos[:, :, None, None], sin[:, :, None, None])
    k = apply_rope(k.reshape(Bsz, L, Hkv, hd), cos[:, :, None], sin[:, :, None])
    v = v.reshape(Bsz, L, Hkv, hd)
    qb = q.reshape(Bsz, nb, W, Hkv, R, hd)
    kb, vb = band_blocks(k), band_blocks(v)
    s = jnp.einsum('bnqgrd,bnkgd->bngrqk', qb, kb, preferred_element_type=jnp.float32) * (hd ** -0.5)
    qi = jnp.arange(W)[:, None]
    kj = jnp.arange(2 * W)[None, :]
    rel = qi + W - kj
    band = (rel >= 0) & (rel < W)
    mask = band[None] & ((jnp.arange(nb)[:, None, None] > 0) | (kj >= W)[None])
    s = jnp.where(mask[None, :, None, None], s, -jnp.inf)
    sink = sinks.astype(jnp.float32).reshape(Hkv, R)[None, None, :, :, None, None]
    mx = jnp.maximum(jnp.max(s, axis=-1, keepdims=True), sink)
    p = jnp.exp(s - mx)
    p = p / (jnp.sum(p, axis=-1, keepdims=True) + jnp.exp(sink - mx))
    o = jnp.einsum('bngrqk,bnkgd->bnqgrd', p.astype(vb.dtype), vb)
    return o.reshape(Bsz, L, Hkv * R * hd)


def short_conv(b, c, h, conv_w):
    return b * causal_dwconv(c * h, conv_w)


def hybrid_mixer(h, cos, sin, w_in, w_out, gdn_conv_w, gdn_a_log, gdn_dt_bias, gdn_norm_w,
                 ssm_conv_w, ssm_conv_b, ssm_a_log, ssm_dt_bias, ssm_d, ssm_norm_w, attn_sinks, sc_conv_w):
    proj = h @ w_in
    (gq, gk, gv, gz, gb, ga, sz, sxbc, sdt, aq, ak, av, cb, cc, ch) = jnp.split(proj, in_proj_split_points(), axis=-1)
    y_a = gated_deltanet(gq, gk, gv, gz, gb, ga, gdn_conv_w, gdn_a_log, gdn_dt_bias, gdn_norm_w)
    y_b = mamba2_ssd(sz, sxbc, sdt, ssm_conv_w, ssm_conv_b, ssm_a_log, ssm_dt_bias, ssm_d, ssm_norm_w)
    y_c = sliding_window_attention(aq, ak, av, attn_sinks, cos, sin)
    y_d = short_conv(cb, cc, ch, sc_conv_w)
    return jnp.concatenate([y_a, y_b, y_c, y_d], axis=-1) @ w_out


def setup_inputs(seed: int = 0) -> dict:
    key = jax.random.key(seed)
    ks = jax.random.split(key, 26)
    f32 = jnp.float32

    def nrm(k, shape, s):
        return jax.random.normal(k, shape, f32) * s

    def gain(k, shape):
        return 1.0 + 0.05 * jax.random.normal(k, shape, f32)

    def dt_bias(k, shape):
        dt = jnp.exp(jax.random.uniform(k, shape, f32, math.log(1e-3), math.log(1e-1)))
        return dt + jnp.log(-jnp.expm1(-dt))

    def a_log(k, shape):
        return jnp.log(jax.random.uniform(k, shape, f32, 1.0, 16.0))

    return {
        'x': nrm(ks[0], (BATCH, SEQ, D_MODEL), 1.0),
        'c': nrm(ks[1], (BATCH, D_MODEL), 1.0),
        'positions': jnp.broadcast_to(jnp.arange(SEQ, dtype=jnp.int32), (BATCH, SEQ)),
        'ada_w': nrm(ks[2], (DEPTH, D_MODEL, 6 * D_MODEL), 0.5 * D_MODEL ** -0.5),
        'ada_b': nrm(ks[3], (DEPTH, 6 * D_MODEL), 0.02),
        'norm_pre_mix': gain(ks[4], (DEPTH, D_MODEL)),
        'norm_post_mix': gain(ks[5], (DEPTH, D_MODEL)),
        'norm_pre_mlp': gain(ks[6], (DEPTH, D_MODEL)),
        'norm_post_mlp': gain(ks[7], (DEPTH, D_MODEL)),
        'w_in': nrm(ks[8], (DEPTH, D_MODEL, IN_WIDTH), D_MODEL ** -0.5),
        'w_out': nrm(ks[9], (DEPTH, MIX_WIDTH, D_MODEL), MIX_WIDTH ** -0.5),
        'gdn_conv_w': nrm(ks[10], (DEPTH, GDN_CONV, 3 * GW), GDN_CONV ** -0.5),
        'gdn_a_log': a_log(ks[11], (DEPTH, GDN_HEADS)),
        'gdn_dt_bias': dt_bias(ks[12], (DEPTH, GDN_HEADS)),
        'gdn_norm_w': gain(ks[13], (DEPTH, GDN_HEAD_DIM)),
        'ssm_conv_w': nrm(ks[14], (DEPTH, SSM_CONV, SSM_CONV_DIM), SSM_CONV ** -0.5),
        'ssm_conv_b': nrm(ks[15], (DEPTH, SSM_CONV_DIM), 0.02),
        'ssm_a_log': a_log(ks[16], (DEPTH, SSM_HEADS)),
        'ssm_dt_bias': dt_bias(ks[17], (DEPTH, SSM_HEADS)),
        'ssm_d': gain(ks[18], (DEPTH, SSM_HEADS)),
        'ssm_norm_w': gain(ks[19], (DEPTH, GW)),
        'attn_sinks': nrm(ks[20], (DEPTH, ATTN_Q_HEADS), 0.5),
        'sc_conv_w': nrm(ks[21], (DEPTH, SC_CONV, GW), SC_CONV ** -0.5),
        'w_up': nrm(ks[22], (DEPTH, D_MODEL, MLP_HIDDEN), D_MODEL ** -0.5),
        'w_down': nrm(ks[23], (DEPTH, MLP_HIDDEN, D_MODEL), MLP_HIDDEN ** -0.5),
    }


def reference(x, c, positions, ada_w, ada_b, norm_pre_mix, norm_post_mix, norm_pre_mlp, norm_post_mlp,
              w_in, w_out, gdn_conv_w, gdn_a_log, gdn_dt_bias, gdn_norm_w, ssm_conv_w, ssm_conv_b,
              ssm_a_log, ssm_dt_bias, ssm_d, ssm_norm_w, attn_sinks, sc_conv_w, w_up, w_down):
    cos, sin = rope_tables(positions)
    c_act = jax.nn.silu(c)
    for i in range(DEPTH):
        mod = (c_act @ ada_w[i] + ada_b[i])[:, None, :]
        shift_a, scale_a, gate_a, shift_m, scale_m, gate_m = jnp.split(mod, 6, axis=-1)
        h = rms_norm(x, norm_pre_mix[i]) * (1.0 + scale_a) + shift_a
        y = hybrid_mixer(h, cos, sin, w_in[i], w_out[i], gdn_conv_w[i], gdn_a_log[i], gdn_dt_bias[i],
                         gdn_norm_w[i], ssm_conv_w[i], ssm_conv_b[i], ssm_a_log[i], ssm_dt_bias[i],
                         ssm_d[i], ssm_norm_w[i], attn_sinks[i], sc_conv_w[i])
        x = x + gate_a * rms_norm(y, norm_post_mix[i])
        h = rms_norm(x, norm_pre_mlp[i]) * (1.0 + scale_m) + shift_m
        y = jnp.square(jax.nn.relu(h @ w_up[i])) @ w_down[i]
        x = x + gate_m * rms_norm(y, norm_post_mlp[i])
    return x
```

```cpp
#include <hip/hip_runtime.h>
#include <cstdio>
#include <cstdint>
namespace pg8 {
#define PG8_LAS __attribute__((address_space(3)))
typedef unsigned short bf16_t;
typedef short bf16x8 __attribute__((ext_vector_type(8)));
typedef float f32x4 __attribute__((ext_vector_type(4)));
typedef unsigned u32x4 __attribute__((ext_vector_type(4)));
constexpr int BM = 256, BK = 64, HALF = 128, HTB = HALF * BK * 2  , STAGE_BYTES = 8 * HTB, NXCD = 8, WGM = 8;

__host__ __device__ __forceinline__ int lds_byte(int r, int c) { const int st = (r >> 4) * 2 + (c >> 5), rr = r & 15, cc = c & 31, ob = rr * 64 + cc * 2; return st * 1024 + (ob ^ (((ob >> 9) & 1) << 5)); }
__host__ __device__ __forceinline__ void stage_rc(int b, int& R, int& C) { const int st = b / 1024, sb = b % 1024, swz = sb ^ (((sb >> 9) & 1) << 5); R = (st >> 1) * 16 + swz / 64; C = (st & 1) * 32 + (swz % 64) / 2; }
__host__ __device__ __forceinline__ int perm32(int rho) { const int n = rho >> 4, i = rho & 15; return 8 * (i >> 2) + 4 * n + (i & 3); }

struct Unit { int pm, pn; };
struct Gemm { const bf16_t* A; const bf16_t* Bt; int M, N, K; };

struct StaticOrder {
    int nM, nN, nwg, G, c;
    __host__ __device__ void init(int M, int N, int G_, int c_) { nM = M / BM; nN = N / BM; nwg = nM * nN; G = G_; c = c_; }
    __host__ __device__ bool next(int i, Unit& u) const {
        const long L = (long)i * G + c; if (L >= nwg) return false;
        int wgid = (int)L; { const int q = nwg / NXCD, r = nwg % NXCD, xcd = wgid % NXCD, off = wgid / NXCD; wgid = (xcd < r ? xcd * (q + 1) : r * (q + 1) + (xcd - r) * q) + off; }
        const int nig = WGM * nN, gid = wgid / nig, fm = gid * WGM, gsz = (nM - fm) < WGM ? (nM - fm) : WGM;
        u.pm = fm + ((wgid % nig) % gsz); u.pn = (wgid % nig) / gsz; return true;
    }
    __device__ __forceinline__ void a_ready(const Unit&) const {}
    __device__ __forceinline__ void done(const Unit&) const {}
};

__device__ __forceinline__ unsigned cvt_pk_bf16(float lo, float hi) { unsigned r; asm volatile("v_cvt_pk_bf16_f32 %0, %1, %2" : "=v"(r) : "v"(lo), "v"(hi)); return r; }
typedef float f32x2 __attribute__((ext_vector_type(2)));
__device__ __forceinline__ f32x2 gelu_pk(f32x2 v) {
    const f32x2 av = __builtin_elementwise_abs(v), d = av * 0.2316418882f + 1.0f;
    f32x2 t; t.x = __builtin_amdgcn_rcpf(d.x); t.y = __builtin_amdgcn_rcpf(d.y);
    f32x2 q = t * 0.5307027145f + (-0.7265760135f); q = q * t + 0.7107068705f; q = q * t + (-0.142248368f); q = q * t + 0.127414796f; q = q * t;
    const f32x2 s = (v * v) * (-0.72134752044f);
    f32x2 e; e.x = __builtin_amdgcn_exp2f(s.x); e.y = __builtin_amdgcn_exp2f(s.y);
    const f32x2 m = v * (q * e), r = v - m;
    f32x2 o; o.x = v.x < 0.f ? m.x : r.x; o.y = v.y < 0.f ? m.y : r.y; return o;
}

template <int ACT  > struct EpiBf16 {
    static constexpr bool PERM = true, AFTER_DRAIN = false; static_assert(ACT == 0 || ACT == 1, "EpiBf16: ACT is 0 (none) or 1 (gelu_pk)");
    bf16_t* O; int ldc; const float* bias; int split_cols; size_t split_stride; float scale0;
    __device__ __forceinline__ void operator()(const f32x4 (&acc)[2][2][4][2], const Unit& u, int wr, int wc, int fr, int fq) const {
        const int row0 = u.pm * BM + wr * 64 + fr; int colt = u.pn * BM; bf16_t* base = O;
        float sc = 1.f; if (split_cols) { const int t = colt / split_cols; base += (size_t)t * split_stride; colt -= t * split_cols; if (t == 0) sc = scale0; }
        const int col0 = colt + wc * 32 + 8 * fq, bcol0 = u.pn * BM + wc * 32 + 8 * fq;
        f32x4 bv[2][2];
#pragma unroll
        for (int bj = 0; bj < 2; ++bj)
#pragma unroll
            for (int n = 0; n < 2; ++n) bv[bj][n] = bias ? *(const f32x4*)(bias + bcol0 + bj * HALF + 4 * n) : (f32x4){0.f, 0.f, 0.f, 0.f};
#pragma unroll
        for (int ai = 0; ai < 2; ++ai)
#pragma unroll
            for (int m = 0; m < 4; ++m) { bf16_t* rowp = base + (size_t)(row0 + ai * HALF + m * 16) * ldc + col0;
#pragma unroll
                for (int bj = 0; bj < 2; ++bj) { f32x4 v0 = acc[ai][bj][m][0] + bv[bj][0], v1 = acc[ai][bj][m][1] + bv[bj][1];
                    if (ACT == 1) { f32x2 a = gelu_pk((f32x2){v0[0], v0[1]}), b = gelu_pk((f32x2){v0[2], v0[3]}), c = gelu_pk((f32x2){v1[0], v1[1]}), d = gelu_pk((f32x2){v1[2], v1[3]});
                        v0 = (f32x4){a.x, a.y, b.x, b.y}; v1 = (f32x4){c.x, c.y, d.x, d.y}; }
                    v0 = v0 * sc; v1 = v1 * sc; u32x4 w; w.x = cvt_pk_bf16(v0[0], v0[1]); w.y = cvt_pk_bf16(v0[2], v0[3]); w.z = cvt_pk_bf16(v1[0], v1[1]); w.w = cvt_pk_bf16(v1[2], v1[3]);
                    *(u32x4*)(rowp + bj * HALF) = w; } }
    }
};

struct PanelStats {
    unsigned* xbuf;
    unsigned* cnt;
    unsigned* tmo;
    int ntn; float eps;
    unsigned code;
    __device__ __forceinline__ bool run(const f32x4 (&v)[2][2][4][2], const Unit& u, int wr, int wc, int fr, int fq, PG8_LAS unsigned char* lds, int wid, int lane) const {
        typedef float f32x2v __attribute__((ext_vector_type(2)));
        PG8_LAS f32x2v* P = (PG8_LAS f32x2v*)lds;
        PG8_LAS f32x2v* S = (PG8_LAS f32x2v*)(lds + 8192);
        PG8_LAS unsigned* flag = (PG8_LAS unsigned*)(lds + 8192 + 2048);
#pragma unroll
        for (int ai = 0; ai < 2; ++ai)
#pragma unroll
            for (int m = 0; m < 4; ++m) {
                float s = 0.f;
#pragma unroll
                for (int bj = 0; bj < 2; ++bj)
#pragma unroll
                    for (int n = 0; n < 2; ++n) { const f32x4 x = v[ai][bj][m][n]; s += (x[0] + x[1]) + (x[2] + x[3]); }
                s += __shfl_xor(s, 16); s += __shfl_xor(s, 32);
                const float mw = s * (1.0f / 64.0f); float q = 0.f;
#pragma unroll
                for (int bj = 0; bj < 2; ++bj)
#pragma unroll
                    for (int n = 0; n < 2; ++n) { const f32x4 d = v[ai][bj][m][n] - mw; q += (d[0] * d[0] + d[1] * d[1]) + (d[2] * d[2] + d[3] * d[3]); }
                q += __shfl_xor(q, 16); q += __shfl_xor(q, 32);
                if (fq == 0) P[(ai * HALF + wr * 64 + m * 16 + fr) * 4 + wc] = (f32x2v){mw, q};
            }
        asm volatile("s_waitcnt lgkmcnt(0)" ::: "memory"); __builtin_amdgcn_s_barrier(); asm volatile("" ::: "memory");
#if defined(BROKEN_EXCHANGE_NO_WAIT)
#warning BROKEN CONTROL BUILD: the row-statistics exchange does not wait; results are wrong by design
        if (blockIdx.x >= 64) { const long long t0_ = clock64(); while (clock64() - t0_ < 60000) __builtin_amdgcn_s_sleep(8); }
#endif
        const int row = wid * 32 + (lane & 31);
        if (lane < 32) {
            const f32x2v a = P[row * 4 + 0], b = P[row * 4 + 1], c = P[row * 4 + 2], d = P[row * 4 + 3];
            const float mt = (a.x + b.x + c.x + d.x) * 0.25f;
            const float da = a.x - mt, db = b.x - mt, dc = c.x - mt, dd = d.x - mt;
            const float m2 = (a.y + b.y) + (c.y + d.y) + 64.0f * ((da * da + db * db) + (dc * dc + dd * dd));
            unsigned long long* slot = (unsigned long long*)xbuf + ((size_t)(u.pm * BM + row) * 4 + u.pn);
            __hip_atomic_store(slot, ((unsigned long long)__float_as_uint(m2) << 32) | __float_as_uint(mt), __ATOMIC_RELAXED, __HIP_MEMORY_SCOPE_AGENT);
        }
        asm volatile("s_waitcnt vmcnt(0)" ::: "memory");
        if (lane == 0) __hip_atomic_fetch_add(cnt + 64 * u.pm, 1u, __ATOMIC_RELAXED, __HIP_MEMORY_SCOPE_AGENT);
        if (wid == 0) {
            bool dead = false; const unsigned long long t0 = __builtin_amdgcn_s_memrealtime(); const unsigned want = 8u * (unsigned)ntn;
            for (;;) {
#if defined(BROKEN_EXCHANGE_NO_WAIT)
                break;
#endif
                if ((unsigned)__builtin_amdgcn_readfirstlane(__hip_atomic_load(cnt + 64 * u.pm, __ATOMIC_RELAXED, __HIP_MEMORY_SCOPE_AGENT)) >= want) break;
                if (__builtin_amdgcn_s_memrealtime() - t0 > 2000000ull) {
                    if (lane == 0) { unsigned expect = 0u; __hip_atomic_compare_exchange_strong(tmo + 1, &expect, code | (unsigned)(u.pm & 0xff), __ATOMIC_RELAXED, __ATOMIC_RELAXED, __HIP_MEMORY_SCOPE_AGENT);
                                     __hip_atomic_store(tmo, 1u, __ATOMIC_RELAXED, __HIP_MEMORY_SCOPE_AGENT); }
                    dead = true; break; }
                __builtin_amdgcn_s_sleep(2);
            }
            __builtin_amdgcn_fence(__ATOMIC_ACQUIRE, "agent");
            if (lane == 0) flag[0] = dead ? 1u : 0u;
        }
        asm volatile("s_waitcnt vmcnt(0) lgkmcnt(0)" ::: "memory"); __builtin_amdgcn_s_barrier(); asm volatile("" ::: "memory");
        const bool bad = flag[0] != 0u;
        if (lane < 32) {
            const unsigned long long* slot = (const unsigned long long*)xbuf + (size_t)(u.pm * BM + row) * 4; float mt[4], m2[4]; float ms = 0.f;
#pragma unroll
            for (int t = 0; t < 4; ++t) { if (t < ntn) { const unsigned long long w = __hip_atomic_load(slot + t, __ATOMIC_RELAXED, __HIP_MEMORY_SCOPE_AGENT); mt[t] = __uint_as_float((unsigned)w); m2[t] = __uint_as_float((unsigned)(w >> 32)); } else { mt[t] = 0.f; m2[t] = 0.f; } ms += mt[t]; }
            const float mean = ms / (float)ntn; float q = 0.f;
#pragma unroll
            for (int t = 0; t < 4; ++t) if (t < ntn) { const float dm = mt[t] - mean; q += m2[t] + 256.0f * dm * dm; }
            S[row] = (f32x2v){mean, 1.0f / sqrtf(q / (256.0f * (float)ntn) + eps)};
        }
        asm volatile("s_waitcnt lgkmcnt(0)" ::: "memory"); __builtin_amdgcn_s_barrier(); asm volatile("" ::: "memory");
        return bad;
    }
};
struct EpiLnRes {
    static constexpr bool PERM = false, AFTER_DRAIN = true;
    const float* base; float* out; int ldc; const float* bias; PanelStats st; unsigned poison;
    __device__ __forceinline__ void fused(f32x4 (&acc)[2][2][4][2], const Unit& u, int wr, int wc, int fr, int fq, PG8_LAS unsigned char* lds, int wid, int lane) const {
        typedef float f32x2v __attribute__((ext_vector_type(2)));
        const PG8_LAS f32x2v* S = (const PG8_LAS f32x2v*)(lds + 8192);
        const int col0 = u.pn * BM + wc * 32 + 4 * fq;
#pragma unroll
        for (int bj = 0; bj < 2; ++bj)
#pragma unroll
            for (int n = 0; n < 2; ++n) { const f32x4 bv = bias ? *(const f32x4*)(bias + col0 + bj * HALF + n * 16) : (f32x4){0.f, 0.f, 0.f, 0.f};
#pragma unroll
                for (int ai = 0; ai < 2; ++ai)
#pragma unroll
                    for (int m = 0; m < 4; ++m) acc[ai][bj][m][n] += bv; }
        f32x4 pre[4][2][2];
#pragma unroll
        for (int m = 0; m < 4; ++m) { const size_t off = (size_t)(u.pm * BM + wr * 64 + m * 16 + fr) * ldc + col0;
#pragma unroll
            for (int bj = 0; bj < 2; ++bj)
#pragma unroll
                for (int n = 0; n < 2; ++n) pre[m][bj][n] = *(const f32x4*)(base + off + bj * HALF + n * 16); }
        const bool bad = st.run(acc, u, wr, wc, fr, fq, lds, wid, lane) || poison != 0u;
        const float qnan = __builtin_nanf("");
#pragma unroll
        for (int ai = 0; ai < 2; ++ai)
#pragma unroll
            for (int m = 0; m < 4; ++m) { const int r = ai * HALF + wr * 64 + m * 16 + fr; const f32x2v sr = S[r]; const size_t off = (size_t)(u.pm * BM + r) * ldc + col0;
#pragma unroll
                for (int bj = 0; bj < 2; ++bj)
#pragma unroll
                    for (int n = 0; n < 2; ++n) { const f32x4 bs = ai == 0 ? pre[m][bj][n] : *(const f32x4*)(base + off + bj * HALF + n * 16); f32x4 o = bs + (acc[ai][bj][m][n] - sr.x) * sr.y;
                        if (bad) o = (f32x4){qnan, qnan, qnan, qnan}; *(f32x4*)(out + off + bj * HALF + n * 16) = o; }
                if (m & 1) asm volatile("" ::: "memory"); }
    }
};
struct EpiLnResLn {
    static constexpr bool PERM = false, AFTER_DRAIN = true;
    const float* base; float* out; bf16_t* xn; int ldc; const float* bias; PanelStats st1, st2; unsigned poison;
    __device__ __forceinline__ void fused(f32x4 (&acc)[2][2][4][2], const Unit& u, int wr, int wc, int fr, int fq, PG8_LAS unsigned char* lds, int wid, int lane) const {
        typedef float f32x2v __attribute__((ext_vector_type(2))); typedef unsigned u32x2v __attribute__((ext_vector_type(2)));
        const PG8_LAS f32x2v* S = (const PG8_LAS f32x2v*)(lds + 8192);
        const int col0 = u.pn * BM + wc * 32 + 4 * fq;
#pragma unroll
        for (int bj = 0; bj < 2; ++bj)
#pragma unroll
            for (int n = 0; n < 2; ++n) { const f32x4 bv = bias ? *(const f32x4*)(bias + col0 + bj * HALF + n * 16) : (f32x4){0.f, 0.f, 0.f, 0.f};
#pragma unroll
                for (int ai = 0; ai < 2; ++ai)
#pragma unroll
                    for (int m = 0; m < 4; ++m) acc[ai][bj][m][n] += bv; }
        bool bad = st1.run(acc, u, wr, wc, fr, fq, lds, wid, lane) || poison != 0u;
        const float qnan = __builtin_nanf("");
#pragma unroll
        for (int ai = 0; ai < 2; ++ai)
#pragma unroll
            for (int m = 0; m < 4; ++m) { const int r = ai * HALF + wr * 64 + m * 16 + fr; const f32x2v sr = S[r]; const size_t off = (size_t)(u.pm * BM + r) * ldc + col0;
#pragma unroll
                for (int bj = 0; bj < 2; ++bj)
#pragma unroll
                    for (int n = 0; n < 2; ++n) { const f32x4 bs = *(const f32x4*)(base + off + bj * HALF + n * 16); acc[ai][bj][m][n] = bs + (acc[ai][bj][m][n] - sr.x) * sr.y; }
                asm volatile("" : "+v"(acc[ai][0][m][0]), "+v"(acc[ai][0][m][1]), "+v"(acc[ai][1][m][0]), "+v"(acc[ai][1][m][1]));
                if (m & 1) asm volatile("" ::: "memory"); }
        const bool bad1 = bad;
        bad = st2.run(acc, u, wr, wc, fr, fq, lds, wid, lane) || bad;
#pragma unroll
        for (int ai = 0; ai < 2; ++ai)
#pragma unroll
            for (int m = 0; m < 4; ++m) { const int r = ai * HALF + wr * 64 + m * 16 + fr; const f32x2v sr = S[r]; const size_t off = (size_t)(u.pm * BM + r) * ldc + col0;
#pragma unroll
                for (int bj = 0; bj < 2; ++bj)
#pragma unroll
                    for (int n = 0; n < 2; ++n) { const f32x4 x1 = acc[ai][bj][m][n]; *(f32x4*)(out + off + bj * HALF + n * 16) = bad1 ? (f32x4){qnan, qnan, qnan, qnan} : x1;
                        const f32x4 o = (x1 - sr.x) * sr.y; u32x2v w; w.x = cvt_pk_bf16(o[0], o[1]); w.y = cvt_pk_bf16(o[2], o[3]);
                        if (bad) { w.x = 0x7fc07fc0u; w.y = 0x7fc07fc0u; } *(u32x2v*)(xn + off + bj * HALF + n * 16) = w; }
                asm volatile("" ::: "memory"); }
    }
};

template <class Epi, class Sched, bool ALIGN_EPI = false, bool SP2 = false>
__device__ __forceinline__ void gemm_phase(PG8_LAS unsigned char* lds, const Gemm g, const Sched& S, const Epi& E) {
    int tid_ = threadIdx.x; asm volatile("" : "+v"(tid_));
    const int tid = tid_, wid = __builtin_amdgcn_readfirstlane(tid >> 6), lane = tid & 63, wr = wid >> 2, wc = wid & 3, fr = lane & 15, fq = lane >> 4;
    const int K = g.K, nt = K / BK;
    unsigned voffA[2], voffB[2];
#pragma unroll
    for (int i = 0; i < 2; ++i) { int R, C; stage_rc(tid * 16 + i * 8192, R, C); const int Rb = Epi::PERM ? ((R & ~31) + perm32(R & 31)) : R;
        voffA[i] = (unsigned)(R * K + C) * 2u; voffB[i] = (unsigned)(Rb * K + C) * 2u; }
    const size_t kstep = (size_t)(BK * 2);
    const size_t hstep = (size_t)HALF * K * 2;
    const size_t tstep = 2 * hstep;
    const unsigned ldsw = (unsigned)wid * 1024u;
    const int aoff = lds_byte(wr * 64 + fr, fq * 8), boff = lds_byte(wc * 32 + fr, fq * 8);
#define PG8_SA(b, h) (((b) * 2 + (h)) * HTB)
#define PG8_SB(b, h) ((4 + (b) * 2 + (h)) * HTB)
#define PG8_STAGE(bufoff, gbase, voff) do { _Pragma("unroll") for (int _i = 0; _i < 2; ++_i) \
        __builtin_amdgcn_global_load_lds((const unsigned*)((const char*)(gbase) + (voff)[_i]), (PG8_LAS unsigned*)(lds + (bufoff) + ldsw + _i * 8192), 16, 0, 0); } while (0)
#define PG8_LDA(dst, b, h) do { _Pragma("unroll") for (int m = 0; m < 4; ++m) _Pragma("unroll") for (int k = 0; k < 2; ++k) dst[m][k] = *(const PG8_LAS bf16x8*)(lds + PG8_SA(b, h) + aoff + m * 2048 + k * 1024); } while (0)
#define PG8_LDB(dst, b, h) do { _Pragma("unroll") for (int n = 0; n < 2; ++n) _Pragma("unroll") for (int k = 0; k < 2; ++k) dst[n][k] = *(const PG8_LAS bf16x8*)(lds + PG8_SB(b, h) + boff + n * 2048 + k * 1024); } while (0)
#define PG8_MMA(ai, bj, At, Bt) do { __builtin_amdgcn_s_setprio(1); _Pragma("unroll") for (int m = 0; m < 4; ++m) _Pragma("unroll") for (int n = 0; n < 2; ++n) _Pragma("unroll") for (int k = 0; k < 2; ++k) \
        acc[ai][bj][m][n] = __builtin_amdgcn_mfma_f32_16x16x32_bf16(Bt[n][k], At[m][k], acc[ai][bj][m][n], 0, 0, 0); __builtin_amdgcn_s_setprio(0); } while (0)
#define PG8_WAIT_V(n) asm volatile("s_waitcnt vmcnt(" #n ")" ::: "memory")
#define PG8_WAIT_L(n) asm volatile("s_waitcnt lgkmcnt(" #n ")" ::: "memory")
#define PG8_BAR __builtin_amdgcn_s_barrier()
#define PG8_SCHED __builtin_amdgcn_sched_barrier(0)
    Unit cur, nxt; int ui = 0;
    if (!S.next(0, cur)) return;
    f32x4 acc[2][2][4][2];
#pragma unroll
    for (int a = 0; a < 2; ++a)
#pragma unroll
        for (int b = 0; b < 2; ++b)
#pragma unroll
            for (int m = 0; m < 4; ++m)
#pragma unroll
                for (int n = 0; n < 2; ++n) acc[a][b][m][n] = (f32x4){0.f, 0.f, 0.f, 0.f};
    bf16x8 At[4][2], B0[2][2], B1[2][2];
    const char* cA = (const char*)g.A + (size_t)cur.pm * tstep; const char* cB = (const char*)g.Bt + (size_t)cur.pn * tstep;
    S.a_ready(cur);
    if constexpr (SP2) {
        PG8_STAGE(PG8_SB(0, 0), cB, voffB); PG8_STAGE(PG8_SB(0, 1), cB + hstep, voffB); PG8_STAGE(PG8_SA(0, 0), cA, voffA); PG8_STAGE(PG8_SA(0, 1), cA + hstep, voffA);
        if (wr == 1) PG8_BAR;
        PG8_WAIT_V(2); PG8_BAR;
        PG8_STAGE(PG8_SB(1, 0), cB + kstep, voffB); PG8_STAGE(PG8_SA(1, 0), cA + kstep, voffA); PG8_STAGE(PG8_SB(1, 1), cB + hstep + kstep, voffB);
        PG8_WAIT_V(6); PG8_BAR;
    } else {
        PG8_STAGE(PG8_SB(0, 0), cB, voffB); PG8_STAGE(PG8_SA(0, 0), cA, voffA); PG8_STAGE(PG8_SB(0, 1), cB + hstep, voffB); PG8_STAGE(PG8_SA(0, 1), cA + hstep, voffA);
        if (wr == 1) PG8_BAR;
        PG8_WAIT_V(4); PG8_BAR;
        PG8_STAGE(PG8_SB(1, 0), cB + kstep, voffB); PG8_STAGE(PG8_SA(1, 0), cA + kstep, voffA); PG8_STAGE(PG8_SB(1, 1), cB + hstep + kstep, voffB);
        PG8_WAIT_V(6); PG8_BAR;
    }
    for (;;) {
        const bool has_next = S.next(ui + 1, nxt);
        const char* nA = has_next ? (const char*)g.A + (size_t)nxt.pm * tstep : cA; const char* nB = has_next ? (const char*)g.Bt + (size_t)nxt.pn * tstep : cB;
        for (int t = 0; t < nt; t += 2) {
            const bool last = (t == nt - 2);
            const char* a1 = cA + (size_t)(t + 1) * kstep;
            const char* a2 = last ? nA : cA + (size_t)(t + 2) * kstep; const char* b2 = last ? nB : cB + (size_t)(t + 2) * kstep;
            const char* a3 = a2 + kstep; const char* b3 = b2 + kstep;
            if (last && has_next) S.a_ready(nxt);
            if constexpr (SP2) {
            PG8_LDB(B0, 0, 0); PG8_LDB(B1, 0, 1); PG8_SCHED; PG8_LDA(At, 0, 0); PG8_STAGE(PG8_SA(1, 1), a1 + hstep, voffA);
            PG8_WAIT_V(8); PG8_WAIT_L(0); PG8_BAR; PG8_MMA(0, 0, At, B0); PG8_MMA(0, 1, At, B1); PG8_BAR; PG8_SCHED;
            PG8_LDA(At, 0, 1); PG8_STAGE(PG8_SB(0, 0), b2, voffB); PG8_STAGE(PG8_SB(0, 1), b2 + hstep, voffB); PG8_STAGE(PG8_SA(0, 0), a2, voffA);
            PG8_WAIT_V(8); PG8_WAIT_L(0); PG8_BAR; PG8_MMA(1, 0, At, B0); PG8_MMA(1, 1, At, B1); PG8_BAR; PG8_SCHED;
            PG8_LDB(B0, 1, 0); PG8_LDB(B1, 1, 1); PG8_SCHED; PG8_LDA(At, 1, 0); PG8_STAGE(PG8_SA(0, 1), a2 + hstep, voffA);
            PG8_WAIT_V(8); PG8_WAIT_L(0); PG8_BAR; PG8_MMA(0, 0, At, B0); PG8_MMA(0, 1, At, B1); PG8_BAR; PG8_SCHED;
            PG8_LDA(At, 1, 1); PG8_STAGE(PG8_SB(1, 0), b3, voffB); PG8_STAGE(PG8_SB(1, 1), b3 + hstep, voffB); PG8_STAGE(PG8_SA(1, 0), a3, voffA);
            PG8_WAIT_V(8); PG8_WAIT_L(0); PG8_BAR; PG8_MMA(1, 0, At, B0); PG8_MMA(1, 1, At, B1); PG8_BAR; PG8_SCHED;
            } else {
            PG8_LDB(B0, 0, 0); PG8_SCHED; PG8_LDA(At, 0, 0); PG8_STAGE(PG8_SA(1, 1), a1 + hstep, voffA);
            PG8_WAIT_L(8); PG8_BAR; PG8_WAIT_L(0); PG8_MMA(0, 0, At, B0); PG8_BAR; PG8_SCHED;
            PG8_LDB(B1, 0, 1); PG8_STAGE(PG8_SB(0, 0), b2, voffB);
            PG8_BAR; PG8_WAIT_L(0); PG8_MMA(0, 1, At, B1); PG8_BAR;
            PG8_LDA(At, 0, 1); PG8_STAGE(PG8_SA(0, 0), a2, voffA);
            PG8_BAR; PG8_WAIT_L(0); PG8_MMA(1, 0, At, B0); PG8_BAR; PG8_SCHED;
            PG8_STAGE(PG8_SB(0, 1), b2 + hstep, voffB);
            PG8_WAIT_V(6); PG8_BAR; PG8_MMA(1, 1, At, B1); PG8_BAR;
            PG8_LDB(B0, 1, 0); PG8_SCHED; PG8_LDA(At, 1, 0); PG8_STAGE(PG8_SA(0, 1), a2 + hstep, voffA);
            PG8_WAIT_L(8); PG8_BAR; PG8_WAIT_L(0); PG8_MMA(0, 0, At, B0); PG8_BAR; PG8_SCHED;
            PG8_LDB(B1, 1, 1); PG8_STAGE(PG8_SB(1, 0), b3, voffB);
            PG8_BAR; PG8_WAIT_L(0); PG8_MMA(0, 1, At, B1); PG8_BAR;
            PG8_LDA(At, 1, 1); PG8_STAGE(PG8_SA(1, 0), a3, voffA);
            PG8_BAR; PG8_WAIT_L(0); PG8_MMA(1, 0, At, B0); PG8_BAR; PG8_SCHED;
            PG8_STAGE(PG8_SB(1, 1), b3 + hstep, voffB);
            PG8_WAIT_V(6); PG8_BAR; PG8_MMA(1, 1, At, B1); PG8_BAR;
            }
        }
        if constexpr (ALIGN_EPI) { if (wr == 0) PG8_BAR; }
        if constexpr (!Epi::AFTER_DRAIN) { E(acc, cur, wr, wc, fr, fq); S.done(cur); }
        if (!has_next) break;
#pragma unroll
        for (int a = 0; a < 2; ++a)
#pragma unroll
            for (int b = 0; b < 2; ++b)
#pragma unroll
                for (int m = 0; m < 4; ++m)
#pragma unroll
                    for (int n = 0; n < 2; ++n) acc[a][b][m][n] = (f32x4){0.f, 0.f, 0.f, 0.f};
        cur = nxt; cA = nA; cB = nB; ++ui;
        if constexpr (ALIGN_EPI) { if (wr == 1) PG8_BAR; }
    }
    PG8_WAIT_V(0);
    if constexpr (!ALIGN_EPI) { if (wr == 0) PG8_BAR; }
    PG8_BAR;
    if constexpr (Epi::AFTER_DRAIN) { E.fused(acc, cur, wr, wc, fr, fq, lds, wid, lane); S.done(cur); }
#undef PG8_SA
#undef PG8_SB
#undef PG8_STAGE
#undef PG8_LDA
#undef PG8_LDB
#undef PG8_MMA
#undef PG8_WAIT_V
#undef PG8_WAIT_L
#undef PG8_BAR
#undef PG8_SCHED
}
}

#ifndef PG8_SP2
#define PG8_SP2 true
#endif
#ifndef PG8_ALIGN
#define PG8_ALIGN true
#endif
#ifndef MK_SPLIT
#define MK_SPLIT 0
#endif
constexpr int NWAVES = 8, NPHASES = 20;
#ifndef MK_EN
#define MK_EN 0xFFFFFFFFu
#endif
#define EN(k) ((MK_EN >> (k)) & 1u)
constexpr int SEQ = 8192, DM = 2048, GW = 512, INW = 5904, NPJ = 6144, HIDN = 8192, DEPTH = 2;
constexpr float EPS = 1e-6f;
constexpr int C_GQ = 0, C_GK = 512, C_GV = 1024, C_GZ = 1536, C_SZ = 2048, C_SX = 2560, C_SB = 3072, C_SC = 3328, C_AQ = 3584, C_AK = 4096, C_AV = 4224,
              C_CB = 4352, C_CC = 4864, C_CH = 5376, C_GB = 5888, C_GA = 5892, C_SDT = 5896;
constexpr size_t MiB = 1u << 20;
constexpr size_t WS_CTL = 0, CTL_ZERO_BYTES = 1 * MiB;
constexpr size_t WS_WIN = 2 * MiB, WIN_L = (size_t)NPJ * DM * 2;
constexpr size_t WS_WOUT = 50 * MiB, WOUT_L = (size_t)DM * DM * 2;
constexpr size_t WS_WUP = 66 * MiB, WUP_L = (size_t)HIDN * DM * 2;
constexpr size_t WS_WDN = 130 * MiB, WDN_L = WUP_L;
constexpr size_t WS_H = 194 * MiB, WS_PROJ = 226 * MiB, WS_YCAT = 322 * MiB, WS_Y = 354 * MiB, WS_HID = 418 * MiB;
constexpr size_t WS_GIMG = 546 * MiB, WS_GU = 577 * MiB, WS_GO = 593 * MiB, WS_SST = 609 * MiB, WS_MISC = 625 * MiB, WS_ROPE = 626 * MiB, WS_END = 628 * MiB;
constexpr int CW_BAR = 4096, CW_MOD = 16384, CW_RSS = 65536;
constexpr int IMG_W = 0, IMG_Q = 17408, IMG_K = 34816, IMG_A = 53248, IMG_BYTES = 62464;
constexpr int RING_BYTES = 131072, LDSCTL_OFF = RING_BYTES, MISC_OFF = LDSCTL_OFF + 320, LDS_BYTES = 147456;

#define LAS __attribute__((address_space(3)))
typedef unsigned short bf16;
typedef float f32x4 __attribute__((ext_vector_type(4)));
typedef float f32x2 __attribute__((ext_vector_type(2)));
typedef float f32x8 __attribute__((ext_vector_type(8)));
typedef float f32x16 __attribute__((ext_vector_type(16)));
typedef short bf16x8 __attribute__((ext_vector_type(8)));
typedef unsigned u32x4 __attribute__((ext_vector_type(4)));
typedef unsigned u32x2 __attribute__((ext_vector_type(2)));
typedef __bf16 bfv8 __attribute__((ext_vector_type(8)));
typedef __bf16 bfv2 __attribute__((ext_vector_type(2)));
#define LDS_WAIT() asm volatile("s_waitcnt lgkmcnt(0)" ::: "memory")
#define VM_WAIT() asm volatile("s_waitcnt vmcnt(0)" ::: "memory")
__device__ __forceinline__ float bf2f(unsigned short u) { return __uint_as_float((unsigned)u << 16); }
__device__ __forceinline__ unsigned short f2bf(float f) { return __builtin_bit_cast(unsigned short, (__bf16)f); }
__device__ __forceinline__ unsigned pk2(float lo, float hi) { f32x2 t = {lo, hi}; return __builtin_bit_cast(unsigned, __builtin_convertvector(t, bfv2)); }
__device__ __forceinline__ float bflo(unsigned w) { return __uint_as_float(w << 16); }
__device__ __forceinline__ float bfhi(unsigned w) { return __uint_as_float(w & 0xffff0000u); }
__device__ __forceinline__ float silu_f(float x) { return x / (1.f + __expf(-x)); }
__device__ __forceinline__ float sigmoid_f(float x) { return 1.f / (1.f + __expf(-x)); }
__device__ __forceinline__ float softplus_f(float x) { return x > 20.f ? x : log1pf(__expf(x)); }
__device__ __forceinline__ float wave_sum(float v) {
#pragma unroll
    for (int o = 1; o < 64; o <<= 1) v += __shfl_xor(v, o);
    return v;
}
__device__ __forceinline__ int permk(int k) { const int q = (k >> 2) & 3; return (k & ~12) | ((((q & 1) << 1) | (q >> 1)) << 2); }
__device__ __forceinline__ int crow(int reg, int h) { return (reg & 3) + 8 * (reg >> 2) + 4 * h; }

#define XB_TMO      128
#define XB_XCNT(j)  (256  + 64 * (j))
#define XB_XSUB(j)  (1280 + 64 * (j))
#define XB_XGEN(j)  (2304 + 64 * (j))
#define XB_TOP      3328
#define XB_TOPGEN   3392
#define XCD_BAR_WORDS 3456
#define XB_SPIN_CAP (1u << 18)

__device__ __forceinline__ unsigned xb_ld(unsigned* p)              { return __hip_atomic_load(p, __ATOMIC_RELAXED, __HIP_MEMORY_SCOPE_AGENT); }
__device__ __forceinline__ unsigned xb_add(unsigned* p, unsigned v) { return __hip_atomic_fetch_add(p, v, __ATOMIC_RELAXED, __HIP_MEMORY_SCOPE_AGENT); }
__device__ __forceinline__ unsigned xb_xcc_id() { return (unsigned)__builtin_amdgcn_s_getreg((3 << 11) | 20) & 0xFu; }
#define XB_SPIN(cond, bar) do { unsigned _sp = 0; while (cond) { __builtin_amdgcn_s_sleep(1); \
    if ((++_sp & 255u) == 0u) { if (xb_ld(&(bar)[XB_TMO])) break; if (_sp > XB_SPIN_CAP) { atomicAdd(&(bar)[XB_TMO], 1u); break; } } } } while (0)

struct XcdBarrier {
    unsigned* bar; unsigned x;
    volatile LAS unsigned* st;
};

__device__ __forceinline__ XcdBarrier xcd_barrier_post(unsigned* bar, volatile LAS unsigned* st) {
    XcdBarrier b; b.bar = bar; b.x = xb_xcc_id(); b.st = st;
    if (threadIdx.x == 0) (void)xb_add(&bar[XB_XCNT(b.x)], 1u);
    return b;
}
__device__ __forceinline__ void xcd_barrier_complete(unsigned* bar, unsigned x, unsigned& nloc, unsigned& nx) {
    const unsigned G = gridDim.x * gridDim.y * gridDim.z;
    unsigned sum, cnt, mine, sp = 0u;
    for (;;) {
        sum = 0u; cnt = 0u; mine = 0u;
#pragma unroll
        for (unsigned j = 0; j < 16; ++j) { const unsigned c = xb_ld(&bar[XB_XCNT(j)]); sum += c; cnt += (c > 0u) ? 1u : 0u; mine = (j == x) ? c : mine; }
        if (sum == G) break;
        __builtin_amdgcn_s_sleep(1);
        if ((++sp & 255u) == 0u) { if (xb_ld(&bar[XB_TMO])) break; if (sp > XB_SPIN_CAP) { atomicAdd(&bar[XB_TMO], 1u); break; } }
    }
    nloc = mine > 0u ? mine : 1u; nx = cnt > 0u ? cnt : 1u;
}

__device__ __forceinline__ void xcd_barrier(const XcdBarrier& b) {
    asm volatile("s_waitcnt vmcnt(0)" ::: "memory");
    __syncthreads();
    if (threadIdx.x == 0) {
        unsigned* bar = b.bar;
        __builtin_amdgcn_s_waitcnt(0);
        unsigned nloc = b.st[0], nx = b.st[1];
        if (nloc == 0u) { xcd_barrier_complete(bar, b.x, nloc, nx); b.st[0] = nloc; b.st[1] = nx; }
        const unsigned old = xb_add(&bar[XB_XSUB(b.x)], 1u);
        const unsigned gen = old / nloc;
        if (old + 1u == (gen + 1u) * nloc) {
            __builtin_amdgcn_fence(__ATOMIC_RELEASE, "agent");
            asm volatile("s_waitcnt vmcnt(0)" ::: "memory");
            const unsigned og = xb_add(&bar[XB_TOP], 1u);
            const unsigned tg = og / nx;
            if (og + 1u == (tg + 1u) * nx) xb_add(&bar[XB_TOPGEN], 1u);
            else XB_SPIN(xb_ld(&bar[XB_TOPGEN]) == tg, bar);
            __builtin_amdgcn_fence(__ATOMIC_ACQUIRE, "agent");
            xb_add(&bar[XB_XGEN(b.x)], 1u);
            asm volatile("s_waitcnt vmcnt(0)" ::: "memory");
        } else {
            XB_SPIN(xb_ld(&bar[XB_XGEN(b.x)]) == gen, bar);
            __builtin_amdgcn_fence(__ATOMIC_ACQUIRE, "agent");
            asm volatile("s_waitcnt vmcnt(0)" ::: "memory");
        }
    }
    __syncthreads();
}


__device__ __forceinline__ int win_src_col(int n) {
    if (n < 2048) return n;
    if (n < 3584) return n + 8;
    if (n < 5888) return n + 16;
    if (n < 5896) return n - 5888 + 2048;
    if (n < 5904) return n - 5896 + 3592;
    return -1;
}
template <int KIND>
__device__ __forceinline__ void p0_transpose_item(const float* W, int K, int Nsrc, bf16* WT, LAS float* scr, int kb, int nb, int lane) {
    const int k0 = 64 * kb, n0 = 32 * nb;
    int sc = n0 + (lane & 31); if (KIND == 1) sc = win_src_col(sc);
#pragma unroll 8
    for (int i = 0; i < 32; ++i) { const int kk = 2 * i + (lane >> 5); scr[kk * 33 + (lane & 31)] = (sc >= 0) ? W[(size_t)(k0 + kk) * Nsrc + sc] : 0.f; }
    LDS_WAIT(); asm volatile("" ::: "memory");
    const int c = lane & 7;
#pragma unroll
    for (int j = 0; j < 4; ++j) { const int n = (lane >> 3) + 8 * j; const LAS float* s = scr + (8 * c) * 33 + n;
        u32x4 o; o.x = pk2(s[0 * 33], s[1 * 33]); o.y = pk2(s[2 * 33], s[3 * 33]); o.z = pk2(s[4 * 33], s[5 * 33]); o.w = pk2(s[6 * 33], s[7 * 33]);
        *(u32x4*)(WT + (size_t)(n0 + n) * K + k0 + 8 * c) = o; }
    LDS_WAIT(); asm volatile("" ::: "memory");
}

__device__ __forceinline__ void phase_prologue_a(LAS unsigned char* lds, const float* c_in, const float* ada_w, const float* ada_b, float* MOD,
                                                 const float* w_in, const float* w_out, const float* w_up, const float* w_down, unsigned char* ws,
                                                 int bid, int tid, int wave, int lane) {
    if (bid < 192) {
        const int L = bid / 96, rem = bid % 96, cb = rem / 16, kr = rem % 16;
        LAS float* sc = (LAS float*)lds;
        if (tid < 128) sc[tid] = silu_f(c_in[kr * 128 + tid]);
        __syncthreads();
        const int col = cb * 2048 + 4 * tid;
        const float* wp = ada_w + ((size_t)L * DM + (size_t)kr * 128) * (6 * DM) + col;
        f32x4 acc = {0.f, 0.f, 0.f, 0.f};
#pragma unroll 8
        for (int k = 0; k < 128; ++k) { const f32x4 w = *(const f32x4*)(wp + (size_t)k * (6 * DM)); acc += w * sc[k]; }
        if (kr == 0) acc += *(const f32x4*)(ada_b + (size_t)L * 6 * DM + col);
        float* mp = MOD + (size_t)L * 6 * DM + col;
        unsafeAtomicAdd(mp + 0, acc.x); unsafeAtomicAdd(mp + 1, acc.y); unsafeAtomicAdd(mp + 2, acc.z); unsafeAtomicAdd(mp + 3, acc.w);
        __syncthreads();
    }
    LAS float* scr = (LAS float*)(lds + wave * 16384);
    const int gw = bid * NWAVES + wave, NGW = 256 * NWAVES;
    for (int it = gw; it < 2 * 24576; it += NGW) {
        const int L = it / 24576; int r = it % 24576;
        if (r < 6144) { p0_transpose_item<1>(w_in + (size_t)L * DM * INW, DM, INW, (bf16*)(ws + WS_WIN + L * WIN_L), scr, r / 192, r % 192, lane); continue; } r -= 6144;
        if (r < 2048) { p0_transpose_item<0>(w_out + (size_t)L * DM * DM, DM, DM, (bf16*)(ws + WS_WOUT + L * WOUT_L), scr, r / 64, r % 64, lane); continue; } r -= 2048;
        if (r < 8192) { p0_transpose_item<0>(w_up + (size_t)L * DM * HIDN, DM, HIDN, (bf16*)(ws + WS_WUP + L * WUP_L), scr, r / 256, r % 256, lane); continue; } r -= 8192;
        p0_transpose_item<0>(w_down + (size_t)L * HIDN * DM, HIDN, DM, (bf16*)(ws + WS_WDN + L * WDN_L), scr, r / 64, r % 64, lane);
    }
}

template <bool HAS_Y, bool HAS_H>
__device__ __forceinline__ void rowpass(const float* xin, const float* y, const float* rowss, const float* gate, const float* npost, float* xout,
                                        const float* npre, const float* scale, const float* shift, bf16* hout, int gw, int NGW, int lane) {
    f32x4 gv[8], pv[8], sv[8];
#pragma unroll
    for (int j = 0; j < 8; ++j) { const int col = 4 * lane + 256 * j;
        if (HAS_Y) gv[j] = *(const f32x4*)(gate + col) * *(const f32x4*)(npost + col);
        if (HAS_H) { pv[j] = *(const f32x4*)(npre + col) * (*(const f32x4*)(scale + col) + 1.0f); sv[j] = *(const f32x4*)(shift + col); } }
    for (int row = gw; row < SEQ; row += NGW) {
        f32x4 v[8];
#pragma unroll
        for (int j = 0; j < 8; ++j) v[j] = *(const f32x4*)(xin + (size_t)row * DM + 4 * lane + 256 * j);
        if (HAS_Y) {
            const float rs = rsqrtf(rowss[row] * (1.0f / DM) + EPS);
#pragma unroll
            for (int j = 0; j < 8; ++j) { const f32x4 yy = *(const f32x4*)(y + (size_t)row * DM + 4 * lane + 256 * j); v[j] += gv[j] * (yy * rs); }
#pragma unroll
            for (int j = 0; j < 8; ++j) *(f32x4*)(xout + (size_t)row * DM + 4 * lane + 256 * j) = v[j];
        }
        if (HAS_H) {
            float ss = 0.f;
#pragma unroll
            for (int j = 0; j < 8; ++j) ss += (v[j].x * v[j].x + v[j].y * v[j].y) + (v[j].z * v[j].z + v[j].w * v[j].w);
            const float r2 = rsqrtf(wave_sum(ss) * (1.0f / DM) + EPS);
#pragma unroll
            for (int j = 0; j < 8; ++j) { const f32x4 hh = v[j] * r2 * pv[j] + sv[j]; u32x2 o; o.x = pk2(hh.x, hh.y); o.y = pk2(hh.z, hh.w);
                *(u32x2*)(hout + (size_t)row * DM + 4 * lane + 256 * j) = o; }
        }
    }
}

namespace pg8 {
template <int ACT> struct EpiB {
    static constexpr bool PERM = true, AFTER_DRAIN = false;
    bf16_t* O; int ldc;
    __device__ __forceinline__ void operator()(const f32x4 (&acc)[2][2][4][2], const Unit& u, int wr, int wc, int fr, int fq) const {
        const int row0 = u.pm * BM + wr * 64 + fr, col0 = u.pn * BM + wc * 32 + 8 * fq;
#pragma unroll
        for (int ai = 0; ai < 2; ++ai)
#pragma unroll
            for (int m = 0; m < 4; ++m) { bf16_t* rowp = O + (size_t)(row0 + ai * HALF + m * 16) * ldc + col0;
#pragma unroll
                for (int bj = 0; bj < 2; ++bj) { f32x4 v0 = acc[ai][bj][m][0], v1 = acc[ai][bj][m][1];
                    if (ACT == 2) { v0 = __builtin_elementwise_max(v0, (f32x4){0.f, 0.f, 0.f, 0.f}); v1 = __builtin_elementwise_max(v1, (f32x4){0.f, 0.f, 0.f, 0.f}); v0 = v0 * v0; v1 = v1 * v1; }
                    u32x4 w; w.x = ::pk2(v0[0], v0[1]); w.y = ::pk2(v0[2], v0[3]); w.z = ::pk2(v1[0], v1[1]); w.w = ::pk2(v1[2], v1[3]);
                    *(u32x4*)(rowp + bj * HALF) = w; } }
    }
};
struct EpiF32SS {
    static constexpr bool PERM = false, AFTER_DRAIN = false;
    float* O; int ldc; float* rowss;
    __device__ __forceinline__ void operator()(const f32x4 (&acc)[2][2][4][2], const Unit& u, int wr, int wc, int fr, int fq) const {
        const int col0 = u.pn * BM + wc * 32 + 4 * fq;
#pragma unroll
        for (int ai = 0; ai < 2; ++ai)
#pragma unroll
            for (int m = 0; m < 4; ++m) { const int row = u.pm * BM + ai * HALF + wr * 64 + m * 16 + fr; float s = 0.f;
#pragma unroll
                for (int bj = 0; bj < 2; ++bj)
#pragma unroll
                    for (int n = 0; n < 2; ++n) { const f32x4 v = acc[ai][bj][m][n]; *(f32x4*)(O + (size_t)row * ldc + col0 + bj * HALF + n * 16) = v;
                        s += (v[0] * v[0] + v[1] * v[1]) + (v[2] * v[2] + v[3] * v[3]); }
                s += __shfl_xor(s, 16); s += __shfl_xor(s, 32);
                if (fq == 0) unsafeAtomicAdd(rowss + row, s); }
    }
};
}

__device__ __forceinline__ void gdn_prep_unit(LAS unsigned char* lds, const bf16* PROJ, const float* conv_w, float a_log_h, float dt_bias_h, int h, int n,
                                              unsigned char* img, float* U, float* gcd, int tid) {
    LAS float* qs = (LAS float*)lds;
    LAS float* ks = (LAS float*)(lds + 33792);
    LAS float* Mm = (LAS float*)(lds + 67584);
    LAS float* At = (LAS float*)(lds + 84992);
    LAS float* sm = (LAS float*)(lds + 102400);
    LAS float *beta = sm, *gc = sm + 64, *eg = sm + 128, *rq = sm + 192, *rk = sm + 256;
    const int t0 = 64 * n;
    __syncthreads();
    {
        const int c = tid & 255, half = tid >> 8, ch = c & 127, isk = c >> 7;
        const int col = (isk ? C_GK : C_GQ) + h * 128 + ch, wcol = (isk ? 512 : 0) + h * 128 + ch;
        const float w0 = conv_w[wcol], w1 = conv_w[1536 + wcol], w2 = conv_w[2 * 1536 + wcol], w3 = conv_w[3 * 1536 + wcol];
        const int tb = t0 + 32 * half - 3;
        float x[35];
#pragma unroll
        for (int j = 0; j < 35; ++j) { const int t = tb + j; x[j] = (t >= 0) ? bf2f(PROJ[(size_t)t * NPJ + col]) : 0.f; }
        LAS float* dst = (isk ? ks : qs) + (32 * half) * 132 + ch;
#pragma unroll
        for (int i = 0; i < 32; ++i) dst[i * 132] = silu_f(w0 * x[i] + w1 * x[i + 1] + w2 * x[i + 2] + w3 * x[i + 3]);
        if (tid < 64) {
            const float b = bf2f(PROJ[(size_t)(t0 + tid) * NPJ + C_GB + h]), a = bf2f(PROJ[(size_t)(t0 + tid) * NPJ + C_GA + h]);
            float g = -__expf(a_log_h) * softplus_f(a + dt_bias_h);
#pragma unroll
            for (int o = 1; o < 64; o <<= 1) { const float up = __shfl_up(g, o); if (tid >= o) g += up; }
            beta[tid] = sigmoid_f(b); gc[tid] = g; eg[tid] = __expf(g);
        }
    }
    __syncthreads();
    {
        const int row = tid >> 2, part = tid & 3; LAS const float* src = (row < 64 ? qs + row * 132 : ks + (row - 64) * 132) + 32 * part;
        float s = 0.f;
#pragma unroll
        for (int i = 0; i < 32; ++i) s += src[i] * src[i];
        s += __shfl_xor(s, 1); s += __shfl_xor(s, 2);
        if (part == 0) { if (row < 64) rq[row] = rsqrtf(s + EPS) * 0.08838834764831845f; else rk[row - 64] = rsqrtf(s + EPS); }
    }
    __syncthreads();
    {
        const int c = tid & 255, half = tid >> 8, ch = c & 127, isk = c >> 7;
        LAS float* dst = (isk ? ks : qs) + (32 * half) * 132 + ch; LAS const float* rr = (isk ? rk : rq) + 32 * half;
#pragma unroll
        for (int i = 0; i < 32; ++i) dst[i * 132] *= rr[i];
    }
    __syncthreads();
    {
        const int blk = tid & 255, bi = blk >> 4, bj = blk & 15, isq = tid >> 8;
        LAS float* dstm = isq ? At : Mm;
        if (bj > bi) {
#pragma unroll
            for (int ii = 0; ii < 4; ++ii) *(LAS f32x4*)(dstm + (4 * bi + ii) * 68 + 4 * bj) = (f32x4){0.f, 0.f, 0.f, 0.f};
        } else {
            LAS const float* ap = (isq ? qs : ks) + (4 * bi) * 132; LAS const float* bp = ks + (4 * bj) * 132;
            float acc[4][4];
#pragma unroll
            for (int ii = 0; ii < 4; ++ii)
#pragma unroll
                for (int jj = 0; jj < 4; ++jj) acc[ii][jj] = 0.f;
#pragma unroll 4
            for (int d = 0; d < 128; d += 4) {
                f32x4 a[4], b[4];
#pragma unroll
                for (int ii = 0; ii < 4; ++ii) { a[ii] = *(LAS const f32x4*)(ap + ii * 132 + d); b[ii] = *(LAS const f32x4*)(bp + ii * 132 + d); }
#pragma unroll
                for (int ii = 0; ii < 4; ++ii)
#pragma unroll
                    for (int jj = 0; jj < 4; ++jj) acc[ii][jj] += (a[ii].x * b[jj].x + a[ii].y * b[jj].y) + (a[ii].z * b[jj].z + a[ii].w * b[jj].w);
            }
#pragma unroll
            for (int ii = 0; ii < 4; ++ii) { const int i = 4 * bi + ii; f32x4 o;
#pragma unroll
                for (int jj = 0; jj < 4; ++jj) { const int j = 4 * bj + jj; const bool keep = isq ? (j <= i) : (j < i);
                    float v = 0.f; if (keep) { v = acc[ii][jj] * __expf(gc[i] - gc[j]); if (!isq) v *= beta[i]; } o[jj] = v; }
                *(LAS f32x4*)(dstm + i * 68 + 4 * bj) = o; }
        }
    }
    __syncthreads();
    if (tid < 256) {
        float x[64];
        if (tid < 128) {
            const int col = C_GV + h * 128 + tid, wcol = 1024 + h * 128 + tid;
            const float w0 = conv_w[wcol], w1 = conv_w[1536 + wcol], w2 = conv_w[2 * 1536 + wcol], w3 = conv_w[3 * 1536 + wcol];
            float p0, p1, p2;
            p0 = (t0 >= 3) ? bf2f(PROJ[(size_t)(t0 - 3) * NPJ + col]) : 0.f; p1 = (t0 >= 2) ? bf2f(PROJ[(size_t)(t0 - 2) * NPJ + col]) : 0.f; p2 = (t0 >= 1) ? bf2f(PROJ[(size_t)(t0 - 1) * NPJ + col]) : 0.f;
#pragma unroll
            for (int i = 0; i < 64; ++i) { const float cur = bf2f(PROJ[(size_t)(t0 + i) * NPJ + col]); x[i] = silu_f(w0 * p0 + w1 * p1 + w2 * p2 + w3 * cur) * beta[i]; p0 = p1; p1 = p2; p2 = cur; }
        } else {
#pragma unroll
            for (int i = 0; i < 64; ++i) x[i] = ks[i * 132 + (tid - 128)] * beta[i] * eg[i];
        }
        int vz; asm volatile("v_mov_b32 %0, 0" : "=v"(vz));
        LAS const float* Mz = Mm + vz;
#pragma unroll
        for (int i = 1; i < 64; ++i) {
            float s0 = x[i], s1 = 0.f;
#pragma unroll
            for (int j4 = 0; j4 < (i + 3) / 4; ++j4) { const f32x4 m = *(LAS const f32x4*)(Mz + i * 68 + 4 * j4);
                if (4 * j4 + 0 < i) s0 -= m.x * x[4 * j4 + 0];
                if (4 * j4 + 1 < i) s1 -= m.y * x[4 * j4 + 1];
                if (4 * j4 + 2 < i) s0 -= m.z * x[4 * j4 + 2];
                if (4 * j4 + 3 < i) s1 -= m.w * x[4 * j4 + 3]; }
            x[i] = s0 + s1;
        }
        if (tid < 128) {
#pragma unroll
            for (int i = 0; i < 64; ++i) U[i * 128 + tid] = x[i];
        } else {
            bf16* wp = (bf16*)(img + IMG_W) + permk(tid - 128);
#pragma unroll
            for (int i = 0; i < 64; ++i) wp[i * 136] = f2bf(-x[i]);
        }
    } else {
        const int t2 = tid - 256; const float gl = gc[63];
        bf16* qp = (bf16*)(img + IMG_Q); bf16* kp = (bf16*)(img + IMG_K); bf16* ap = (bf16*)(img + IMG_A);
        for (int e = t2; e < 8192; e += 256) { const int t = e >> 7, k = e & 127; qp[t * 136 + permk(k)] = f2bf(qs[t * 132 + k] * eg[t]); }
        for (int e = t2; e < 8192; e += 256) { const int t = e >> 7, d = e & 127; kp[d * 72 + permk(t)] = f2bf(ks[t * 132 + d] * __expf(gl - gc[t])); }
        for (int e = t2; e < 4096; e += 256) { const int i = e >> 6, j = e & 63; ap[i * 72 + permk(j)] = f2bf(At[i * 68 + j]); }
        if (t2 == 0) *gcd = __expf(gl);
    }
}

__device__ __forceinline__ bf16x8 pack8(const f32x16& x, int s) {
    f32x8 t;
#pragma unroll
    for (int j = 0; j < 8; ++j) t[j] = x[8 * s + j];
    return __builtin_bit_cast(bf16x8, __builtin_convertvector(t, bfv8));
}
__device__ __forceinline__ void gdn_post(const float* GO, const bf16* PROJ, const float* norm_w, bf16* YCAT, int h, int t0, int a) {
    const int tok = a >> 2, part = a & 3; const size_t t = (size_t)(t0 + tok);
    const float* op = GO + t * GW + h * 128 + 32 * part;
    f32x4 o[8]; float ss = 0.f;
#pragma unroll
    for (int i = 0; i < 8; ++i) { o[i] = *(const f32x4*)(op + 4 * i); ss += (o[i].x * o[i].x + o[i].y * o[i].y) + (o[i].z * o[i].z + o[i].w * o[i].w); }
    ss += __shfl_xor(ss, 1); ss += __shfl_xor(ss, 2);
    const float rs = rsqrtf(ss * (1.0f / 128.0f) + EPS);
    const bf16* zp = PROJ + t * NPJ + C_GZ + h * 128 + 32 * part; bf16* yp = YCAT + t * DM + h * 128 + 32 * part; const float* nw = norm_w + 32 * part;
#pragma unroll
    for (int i = 0; i < 4; ++i) { const u32x4 z = *(const u32x4*)(zp + 8 * i); const f32x4 n0 = *(const f32x4*)(nw + 8 * i), n1 = *(const f32x4*)(nw + 8 * i + 4);
        const f32x4 a0 = o[2 * i], a1 = o[2 * i + 1]; u32x4 w;
        w.x = pk2(a0.x * rs * n0.x * silu_f(bflo(z.x)), a0.y * rs * n0.y * silu_f(bfhi(z.x)));
        w.y = pk2(a0.z * rs * n0.z * silu_f(bflo(z.y)), a0.w * rs * n0.w * silu_f(bfhi(z.y)));
        w.z = pk2(a1.x * rs * n1.x * silu_f(bflo(z.z)), a1.y * rs * n1.y * silu_f(bfhi(z.z)));
        w.w = pk2(a1.z * rs * n1.z * silu_f(bflo(z.w)), a1.w * rs * n1.w * silu_f(bfhi(z.w)));
        *(u32x4*)(yp + 8 * i) = w; }
}
__device__ __forceinline__ void gdn_scan(LAS unsigned char* lds, const unsigned char* IMG, const float* Uall, const float* GCD, float* GO, const bf16* PROJ,
                                         const float* norm_w, bf16* YCAT, int h, int tid) {
    const int wave = __builtin_amdgcn_readfirstlane(tid >> 6), lane = tid & 63, r = lane & 31, hh = lane >> 5;
    const unsigned char* img_h = IMG + (size_t)h * 128 * IMG_BYTES;
    __syncthreads();
    { unsigned off = 16u * (unsigned)tid;
#pragma unroll
      for (int k = 0; k < 8; ++k) { const unsigned o = off + 8192u * k; if (o < (unsigned)IMG_BYTES) *(LAS u32x4*)(lds + o) = *(const u32x4*)(img_h + o); } }
    f32x16 Sacc[4]; bf16x8 Sbf[4][2]; f32x16 Ucur[2];
    const int c0 = 32 * wave;
    const unsigned uvo = (unsigned)(r + 512 * hh), gvo = (unsigned)(r + 4 * hh * GW);
    if (wave < 4) {
#pragma unroll
        for (int T = 0; T < 4; ++T) {
#pragma unroll
            for (int i = 0; i < 16; ++i) Sacc[T][i] = 0.f;
            Sbf[T][0] = (bf16x8){0, 0, 0, 0, 0, 0, 0, 0}; Sbf[T][1] = (bf16x8){0, 0, 0, 0, 0, 0, 0, 0}; }
        const float* ub = Uall + (size_t)(h * 128) * 8192 + c0;
#pragma unroll
        for (int mt = 0; mt < 2; ++mt)
#pragma unroll
            for (int i = 0; i < 16; ++i) Ucur[mt][i] = ub[(32 * mt + crow(i, 0)) * 128 + uvo];
    }
    __syncthreads();
    for (int n = 0; n < 128; ++n) {
        LAS const unsigned char* buf = lds + (n & 1) * IMG_BYTES;
        if (wave < 4) {
            f32x16 Vn[2]; bf16x8 Vbf[2][2];
            Vn[0] = Ucur[0]; Vn[1] = Ucur[1];
            const float cd = GCD[h * 128 + n];
#pragma unroll
            for (int mt = 0; mt < 2; ++mt)
#pragma unroll
                for (int T = 0; T < 4; ++T)
#pragma unroll
                    for (int s = 0; s < 2; ++s) { const bf16x8 A = *(LAS const bf16x8*)(buf + IMG_W + (32 * mt + r) * 272 + (32 * T + 16 * s + 8 * hh) * 2);
                        Vn[mt] = __builtin_amdgcn_mfma_f32_32x32x16_bf16(A, Sbf[T][s], Vn[mt], 0, 0, 0); }
#pragma unroll
            for (int mt = 0; mt < 2; ++mt) { Vbf[mt][0] = pack8(Vn[mt], 0); Vbf[mt][1] = pack8(Vn[mt], 1); }
            __builtin_amdgcn_sched_barrier(0);
            if (n + 1 < 128) { const float* ub = Uall + (size_t)(h * 128 + n + 1) * 8192 + c0;
                unsigned uv = uvo; asm volatile("" : "+v"(uv));
#pragma unroll
                for (int mt = 0; mt < 2; ++mt)
#pragma unroll
                    for (int i = 0; i < 16; ++i) Ucur[mt][i] = ub[(32 * mt + crow(i, 0)) * 128 + uv]; }
#pragma unroll
            for (int mt = 0; mt < 2; ++mt) {
                f32x16 O;
#pragma unroll
                for (int i = 0; i < 16; ++i) O[i] = 0.f;
#pragma unroll
                for (int T = 0; T < 4; ++T)
#pragma unroll
                    for (int s = 0; s < 2; ++s) { const bf16x8 A = *(LAS const bf16x8*)(buf + IMG_Q + (32 * mt + r) * 272 + (32 * T + 16 * s + 8 * hh) * 2);
                        O = __builtin_amdgcn_mfma_f32_32x32x16_bf16(A, Sbf[T][s], O, 0, 0, 0); }
#pragma unroll
                for (int m2 = 0; m2 < 2; ++m2)
#pragma unroll
                    for (int s = 0; s < 2; ++s) { const bf16x8 A = *(LAS const bf16x8*)(buf + IMG_A + (32 * mt + r) * 144 + (32 * m2 + 16 * s + 8 * hh) * 2);
                        O = __builtin_amdgcn_mfma_f32_32x32x16_bf16(A, Vbf[m2][s], O, 0, 0, 0); }
                float* gp = GO + (size_t)(64 * n + 32 * mt) * GW + h * 128 + c0;
                unsigned gv = gvo; asm volatile("" : "+v"(gv));
#pragma unroll
                for (int i = 0; i < 16; ++i) gp[crow(i, 0) * GW + gv] = O[i];
            }
            __builtin_amdgcn_sched_barrier(0);
#pragma unroll
            for (int T = 0; T < 4; ++T) {
                f32x16 acc = Sacc[T] * cd;
#pragma unroll
                for (int m2 = 0; m2 < 2; ++m2)
#pragma unroll
                    for (int s = 0; s < 2; ++s) { const bf16x8 A = *(LAS const bf16x8*)(buf + IMG_K + (32 * T + r) * 144 + (32 * m2 + 16 * s + 8 * hh) * 2);
                        acc = __builtin_amdgcn_mfma_f32_32x32x16_bf16(A, Vbf[m2][s], acc, 0, 0, 0); }
                Sacc[T] = acc; Sbf[T][0] = pack8(acc, 0); Sbf[T][1] = pack8(acc, 1);
            }
        } else {
            const int a = tid - 256;
            if (n + 1 < 128) { const unsigned char* src = img_h + (size_t)(n + 1) * IMG_BYTES; LAS unsigned char* dst = lds + ((n + 1) & 1) * IMG_BYTES;
                unsigned off = 16u * (unsigned)a; asm volatile("" : "+v"(off));
#pragma unroll
                for (int k = 0; k < 16; ++k) { const unsigned o = off + 4096u * k; if (o < (unsigned)IMG_BYTES) *(LAS u32x4*)(dst + o) = *(const u32x4*)(src + o); } }
            if (n >= 1) gdn_post(GO, PROJ, norm_w, YCAT, h, 64 * (n - 1), a);
        }
        asm volatile("s_waitcnt vmcnt(0) lgkmcnt(0)" ::: "memory");
        __syncthreads();
    }
    if (wave >= 4) gdn_post(GO, PROJ, norm_w, YCAT, h, 64 * 127, tid - 256);
}

__device__ __forceinline__ void ssd_step1_unit(LAS unsigned char* lds, const bf16* PROJ, const float* conv_w, const float* conv_b, float a_log_h, float dt_bias_h,
                                               int c, int h, float* SST, float* SCD, int tid) {
    LAS float* xw = (LAS float*)lds;
    LAS float* bm = (LAS float*)(lds + 34816);
    LAS float* dtv = (LAS float*)(lds + 102400);
    LAS float* dac = dtv + 128;
    LAS float* tmp = dtv + 256;
    const int g = h >> 2, t0 = 128 * c;
    __syncthreads();
    if (tid < 128) { const float d = softplus_f(bf2f(PROJ[(size_t)(t0 + tid) * NPJ + C_SDT + h]) + dt_bias_h); dtv[tid] = d; tmp[tid] = -__expf(a_log_h) * d; }
    __syncthreads();
    if (tid < 128) { float s = 0.f; for (int i = 0; i <= tid; ++i) s += tmp[i]; dac[tid] = s; }
    __syncthreads();
    {
        const int p = tid & 63, lq = tid >> 6, cch = h * 64 + p, col = C_SX + cch;
        const float w0 = conv_w[cch], w1 = conv_w[1024 + cch], w2 = conv_w[2048 + cch], w3 = conv_w[3072 + cch], bb = conv_b[cch];
        const int tb = t0 + 16 * lq - 3; float x[19];
#pragma unroll
        for (int j = 0; j < 19; ++j) { const int t = tb + j; x[j] = (t >= 0) ? bf2f(PROJ[(size_t)t * NPJ + col]) : 0.f; }
        const float dl = dac[127];
#pragma unroll
        for (int i = 0; i < 16; ++i) { const int l = 16 * lq + i; xw[l * 68 + p] = silu_f(w0 * x[i] + w1 * x[i + 1] + w2 * x[i + 2] + w3 * x[i + 3] + bb) * dtv[l] * __expf(dl - dac[l]); }
    }
    {
        const int nn = tid & 127, lq = tid >> 7, cch = 512 + g * 128 + nn, col = C_SX + cch;
        const float w0 = conv_w[cch], w1 = conv_w[1024 + cch], w2 = conv_w[2048 + cch], w3 = conv_w[3072 + cch], bb = conv_b[cch];
        const int tb = t0 + 32 * lq - 3; float x[35];
#pragma unroll
        for (int j = 0; j < 35; ++j) { const int t = tb + j; x[j] = (t >= 0) ? bf2f(PROJ[(size_t)t * NPJ + col]) : 0.f; }
#pragma unroll
        for (int i = 0; i < 32; ++i) bm[(32 * lq + i) * 132 + nn] = silu_f(w0 * x[i] + w1 * x[i + 1] + w2 * x[i + 2] + w3 * x[i + 3] + bb);
    }
    __syncthreads();
    {
        const int p0 = 4 * (tid & 15), n0 = 4 * (tid >> 4);
        float acc[4][4];
#pragma unroll
        for (int i = 0; i < 4; ++i)
#pragma unroll
            for (int j = 0; j < 4; ++j) acc[i][j] = 0.f;
#pragma unroll 4
        for (int l = 0; l < 128; ++l) { const f32x4 a = *(LAS const f32x4*)(xw + l * 68 + p0), b = *(LAS const f32x4*)(bm + l * 132 + n0);
#pragma unroll
            for (int i = 0; i < 4; ++i)
#pragma unroll
                for (int j = 0; j < 4; ++j) acc[i][j] += a[i] * b[j]; }
        float* sp = SST + ((size_t)(c * 8 + h) * 64 + p0) * 128 + n0;
#pragma unroll
        for (int i = 0; i < 4; ++i) *(f32x4*)(sp + i * 128) = (f32x4){acc[i][0], acc[i][1], acc[i][2], acc[i][3]};
        if (tid == 0) SCD[c * 8 + h] = __expf(dac[127]);
    }
}
__device__ __forceinline__ void ssd_scan(float* SST, const float* SCD, int bid, int tid) {
    if (tid < 256) {
        const int e = bid * 256 + tid, h = e >> 13; float S = 0.f;
#pragma unroll 8
        for (int c = 0; c < 64; ++c) { const float v = SST[(size_t)c * 65536 + e]; SST[(size_t)c * 65536 + e] = S; S = S * SCD[c * 8 + h] + v; }
    }
}
__device__ __forceinline__ void ssd_step3_unit(LAS unsigned char* lds, const bf16* PROJ, const float* conv_w, const float* conv_b, const float* a_log, const float* dt_bias,
                                               const float* d_skip, const float* norm_w, const float* SST, bf16* YCAT, int c, int g, int lq, int tid) {
    LAS float* cm = (LAS float*)lds;
    LAS float* bmt = (LAS float*)(lds + 16896);
    LAS float* xs = (LAS float*)(lds + 33792);
    LAS float* G = (LAS float*)(lds + 67072);
    LAS float* prv = (LAS float*)(lds + 85504);
    LAS float* dtv = (LAS float*)(lds + 122368);
    LAS float* dac = dtv + 512;
    LAS float* tmp = dtv + 1024;
    const int t0 = 128 * c, tq = t0 + 32 * lq;
    __syncthreads();
    { const int hq = tid >> 7, l = tid & 127, h = g * 4 + hq; const float d = softplus_f(bf2f(PROJ[(size_t)(t0 + l) * NPJ + C_SDT + h]) + dt_bias[h]); dtv[tid] = d; tmp[tid] = -__expf(a_log[h]) * d; }
    __syncthreads();
    { const int hq = tid >> 7, l = tid & 127; float s = 0.f; for (int i = 0; i <= l; ++i) s += tmp[hq * 128 + i]; dac[tid] = s; }
    {
        const int nn = tid & 127, q4 = tid >> 7, cch = 768 + g * 128 + nn, col = C_SX + cch;
        const float w0 = conv_w[cch], w1 = conv_w[1024 + cch], w2 = conv_w[2048 + cch], w3 = conv_w[3072 + cch], bb = conv_b[cch];
        const int tb = tq + 8 * q4 - 3; float x[11];
#pragma unroll
        for (int j = 0; j < 11; ++j) { const int t = tb + j; x[j] = (t >= 0) ? bf2f(PROJ[(size_t)t * NPJ + col]) : 0.f; }
#pragma unroll
        for (int i = 0; i < 8; ++i) cm[(8 * q4 + i) * 132 + nn] = silu_f(w0 * x[i] + w1 * x[i + 1] + w2 * x[i + 2] + w3 * x[i + 3] + bb);
    }
    const int lb = tid >> 6, cb4 = tid & 63, hq_t = cb4 >> 4;
    float y[4][4];
#pragma unroll
    for (int i = 0; i < 4; ++i)
#pragma unroll
        for (int j = 0; j < 4; ++j) y[i][j] = 0.f;
    for (int st = 0; st <= lq; ++st) {
        __syncthreads();
        const int ts = t0 + 32 * st;
        {
            const int nn = tid & 127, q4 = tid >> 7, cch = 512 + g * 128 + nn, col = C_SX + cch;
            const float w0 = conv_w[cch], w1 = conv_w[1024 + cch], w2 = conv_w[2048 + cch], w3 = conv_w[3072 + cch], bb = conv_b[cch];
            const int tb = ts + 8 * q4 - 3; float x[11];
#pragma unroll
            for (int j = 0; j < 11; ++j) { const int t = tb + j; x[j] = (t >= 0) ? bf2f(PROJ[(size_t)t * NPJ + col]) : 0.f; }
#pragma unroll
            for (int i = 0; i < 8; ++i) bmt[(8 * q4 + i) * 132 + nn] = silu_f(w0 * x[i] + w1 * x[i + 1] + w2 * x[i + 2] + w3 * x[i + 3] + bb);
        }
        {
            const int ch = tid & 255, half = tid >> 8, cch = g * 256 + ch, col = C_SX + cch;
            const float w0 = conv_w[cch], w1 = conv_w[1024 + cch], w2 = conv_w[2048 + cch], w3 = conv_w[3072 + cch], bb = conv_b[cch];
            const int tb = ts + 16 * half - 3; float x[19];
#pragma unroll
            for (int j = 0; j < 19; ++j) { const int t = tb + j; x[j] = (t >= 0) ? bf2f(PROJ[(size_t)t * NPJ + col]) : 0.f; }
#pragma unroll
            for (int i = 0; i < 16; ++i) xs[(16 * half + i) * 260 + ch] = silu_f(w0 * x[i] + w1 * x[i + 1] + w2 * x[i + 2] + w3 * x[i + 3] + bb);
        }
        __syncthreads();
        {
            const int l = tid >> 4, s0 = 2 * (tid & 15);
            float a0 = 0.f, a1 = 0.f;
#pragma unroll 4
            for (int nn = 0; nn < 128; nn += 4) { const f32x4 cv = *(LAS const f32x4*)(cm + l * 132 + nn), b0 = *(LAS const f32x4*)(bmt + s0 * 132 + nn), b1 = *(LAS const f32x4*)(bmt + (s0 + 1) * 132 + nn);
                a0 += (cv.x * b0.x + cv.y * b0.y) + (cv.z * b0.z + cv.w * b0.w); a1 += (cv.x * b1.x + cv.y * b1.y) + (cv.z * b1.z + cv.w * b1.w); }
            const int Labs = 32 * lq + l, S0 = 32 * st + s0;
#pragma unroll
            for (int hq = 0; hq < 4; ++hq) {
                const float dl = dac[hq * 128 + Labs];
                G[(hq * 32 + l) * 36 + s0] = (S0 <= Labs) ? a0 * __expf(dl - dac[hq * 128 + S0]) * dtv[hq * 128 + S0] : 0.f;
                G[(hq * 32 + l) * 36 + s0 + 1] = (S0 + 1 <= Labs) ? a1 * __expf(dl - dac[hq * 128 + S0 + 1]) * dtv[hq * 128 + S0 + 1] : 0.f;
            }
        }
        __syncthreads();
        {
            LAS const float* gp = G + (hq_t * 32 + 4 * lb) * 36;
#pragma unroll 4
            for (int s = 0; s < 32; ++s) { const f32x4 xv = *(LAS const f32x4*)(xs + s * 260 + 4 * cb4);
#pragma unroll
                for (int i = 0; i < 4; ++i) { const float w = gp[i * 36 + s];
#pragma unroll
                    for (int j = 0; j < 4; ++j) y[i][j] += w * xv[j]; } }
            if (st == lq) { const float dsk = d_skip[g * 4 + hq_t];
#pragma unroll
                for (int i = 0; i < 4; ++i) { const f32x4 xv = *(LAS const f32x4*)(xs + (4 * lb + i) * 260 + 4 * cb4);
#pragma unroll
                    for (int j = 0; j < 4; ++j) y[i][j] += dsk * xv[j]; } }
        }
    }
    float yo[4][4];
#pragma unroll
    for (int i = 0; i < 4; ++i)
#pragma unroll
        for (int j = 0; j < 4; ++j) yo[i][j] = 0.f;
    for (int nt = 0; nt < 4; ++nt) {
        __syncthreads();
        { const int ch = tid >> 1, half = tid & 1; const float* sp = SST + ((size_t)(c * 8 + g * 4 + (ch >> 6)) * 64 + (ch & 63)) * 128 + 32 * nt + 16 * half;
#pragma unroll
            for (int i = 0; i < 4; ++i) *(LAS f32x4*)(prv + ch * 36 + 16 * half + 4 * i) = *(const f32x4*)(sp + 4 * i); }
        __syncthreads();
#pragma unroll 2
        for (int nn = 0; nn < 32; nn += 4) {
            f32x4 cv[4], pv[4];
#pragma unroll
            for (int i = 0; i < 4; ++i) { cv[i] = *(LAS const f32x4*)(cm + (4 * lb + i) * 132 + 32 * nt + nn); pv[i] = *(LAS const f32x4*)(prv + (4 * cb4 + i) * 36 + nn); }
#pragma unroll
            for (int i = 0; i < 4; ++i)
#pragma unroll
                for (int j = 0; j < 4; ++j) yo[i][j] += (cv[i].x * pv[j].x + cv[i].y * pv[j].y) + (cv[i].z * pv[j].z + cv[i].w * pv[j].w);
        }
    }
    const f32x4 nw = *(const f32x4*)(norm_w + g * 256 + 4 * cb4);
#pragma unroll
    for (int i = 0; i < 4; ++i) {
        const int l = 4 * lb + i; const size_t t = (size_t)(tq + l);
        const float ed = __expf(dac[hq_t * 128 + 32 * lq + l]);
        const u32x2 z = *(const u32x2*)(PROJ + t * NPJ + C_SZ + g * 256 + 4 * cb4);
        f32x4 v;
        v.x = (y[i][0] + ed * yo[i][0]) * silu_f(bflo(z.x)); v.y = (y[i][1] + ed * yo[i][1]) * silu_f(bfhi(z.x));
        v.z = (y[i][2] + ed * yo[i][2]) * silu_f(bflo(z.y)); v.w = (y[i][3] + ed * yo[i][3]) * silu_f(bfhi(z.y));
        const float ss = wave_sum((v.x * v.x + v.y * v.y) + (v.z * v.z + v.w * v.w));
        const float rs = rsqrtf(ss * (1.0f / 256.0f) + EPS);
        u32x2 o; o.x = pk2(v.x * rs * nw.x, v.y * rs * nw.y); o.y = pk2(v.z * rs * nw.z, v.w * rs * nw.w);
        *(u32x2*)(YCAT + t * DM + 512 + g * 256 + 4 * cb4) = o;
    }
}

__device__ __forceinline__ void swa_unit(LAS unsigned char* lds, const bf16* PROJ, const f32x2* ROPE, const float* sinks, bf16* YCAT, int b, int g, int hp, int tid) {
    LAS float* Kl = (LAS float*)lds;
    LAS float* Vl = (LAS float*)(lds + 65536);
    __syncthreads();
    {
        const int key = tid >> 1, half = tid & 1; const int t = 128 * (b - 1) + key;
        LAS float* kd = Kl + key * 64; LAS float* vd = Vl + key * 64 + 32 * half;
        if (t < 0) {
#pragma unroll
            for (int i = 0; i < 16; ++i) { kd[16 * half + i] = 0.f; kd[32 + 16 * half + i] = 0.f; }
#pragma unroll
            for (int i = 0; i < 32; ++i) vd[i] = 0.f;
        } else {
            const bf16* kp = PROJ + (size_t)t * NPJ + C_AK + g * 64 + 16 * half; const bf16* vp = PROJ + (size_t)t * NPJ + C_AV + g * 64 + 32 * half;
            const f32x2* rp = ROPE + (size_t)t * 32 + 16 * half;
#pragma unroll
            for (int i = 0; i < 16; ++i) { const float k1 = bf2f(kp[i]), k2 = bf2f(kp[32 + i]); const f32x2 cs = rp[i];
                kd[16 * half + i] = k1 * cs.x - k2 * cs.y; kd[32 + 16 * half + i] = k2 * cs.x + k1 * cs.y; }
#pragma unroll
            for (int i = 0; i < 4; ++i) { const u32x4 v = *(const u32x4*)(vp + 8 * i);
                *(LAS f32x4*)(vd + 8 * i) = (f32x4){bflo(v.x), bfhi(v.x), bflo(v.y), bfhi(v.y)}; *(LAS f32x4*)(vd + 8 * i + 4) = (f32x4){bflo(v.z), bfhi(v.z), bflo(v.w), bfhi(v.w)}; }
        }
    }
    const int half = tid & 1, qi = (tid >> 1) & 127, head = g * 4 + hp * 2 + (tid >> 8); const size_t tq = (size_t)(128 * b + qi);
    float q[32];
    {
        const bf16* qp = PROJ + tq * NPJ + C_AQ + head * 64 + 32 * half; const f32x2* rp = ROPE + tq * 32;
        const float sg = half ? 0.125f : -0.125f;
#pragma unroll
        for (int i = 0; i < 32; ++i) { const float mine = bf2f(qp[i]); const float other = __shfl_xor(mine, 1); const f32x2 cs = rp[i];
            q[i] = mine * cs.x * 0.125f + other * cs.y * sg; }
    }
    __syncthreads();
    float acc[32];
#pragma unroll
    for (int i = 0; i < 32; ++i) acc[i] = 0.f;
    float mrun = sinks[head], lrun = 1.0f;
    const int i0 = qi & ~31;
    const int kmin = (b == 0) ? 128 : 0;
    for (int kg = 0; kg < 40; ++kg) {
        const int kj0 = i0 + 4 * kg;
        float s[4];
#pragma unroll
        for (int u = 0; u < 4; ++u) { LAS const float* kr = Kl + (kj0 + u) * 64 + 32 * half; float d0 = 0.f, d1 = 0.f;
#pragma unroll
            for (int d = 0; d < 32; d += 4) { const f32x4 kv = *(LAS const f32x4*)(kr + d); d0 += q[d] * kv.x + q[d + 2] * kv.z; d1 += q[d + 1] * kv.y + q[d + 3] * kv.w; }
            s[u] = d0 + d1; }
#pragma unroll
        for (int u = 0; u < 4; ++u) { s[u] += __shfl_xor(s[u], 1); const int kj = kj0 + u, rel = qi + 128 - kj; if (!(rel >= 0 && rel < 128 && kj >= kmin)) s[u] = -INFINITY; }
        const float mnew = fmaxf(fmaxf(fmaxf(s[0], s[1]), fmaxf(s[2], s[3])), mrun);
        const float alpha = __expf(mrun - mnew);
        float p[4];
#pragma unroll
        for (int u = 0; u < 4; ++u) p[u] = __expf(s[u] - mnew);
        lrun = lrun * alpha + (p[0] + p[1]) + (p[2] + p[3]); mrun = mnew;
#pragma unroll
        for (int i = 0; i < 32; ++i) acc[i] *= alpha;
#pragma unroll
        for (int u = 0; u < 4; ++u) { LAS const float* vr = Vl + (kj0 + u) * 64 + 32 * half;
#pragma unroll
            for (int d = 0; d < 32; d += 4) { const f32x4 vv = *(LAS const f32x4*)(vr + d); acc[d] += p[u] * vv.x; acc[d + 1] += p[u] * vv.y; acc[d + 2] += p[u] * vv.z; acc[d + 3] += p[u] * vv.w; } }
        asm volatile("" ::: "memory");
    }
    const float inv = 1.0f / lrun;
    bf16* yp = YCAT + tq * DM + 1024 + head * 64 + 32 * half;
#pragma unroll
    for (int i = 0; i < 4; ++i) { u32x4 w; w.x = pk2(acc[8 * i] * inv, acc[8 * i + 1] * inv); w.y = pk2(acc[8 * i + 2] * inv, acc[8 * i + 3] * inv);
        w.z = pk2(acc[8 * i + 4] * inv, acc[8 * i + 5] * inv); w.w = pk2(acc[8 * i + 6] * inv, acc[8 * i + 7] * inv); *(u32x4*)(yp + 8 * i) = w; }
}

__device__ __forceinline__ void sc_unit(const bf16* PROJ, const float* conv_w, bf16* YCAT, int rb, int tid) {
    const int c = tid, t0 = 32 * rb;
    const float w0 = conv_w[c], w1 = conv_w[512 + c], w2 = conv_w[1024 + c];
    float p0 = 0.f, p1 = 0.f;
    if (t0 >= 2) p0 = bf2f(PROJ[(size_t)(t0 - 2) * NPJ + C_CC + c]) * bf2f(PROJ[(size_t)(t0 - 2) * NPJ + C_CH + c]);
    if (t0 >= 1) p1 = bf2f(PROJ[(size_t)(t0 - 1) * NPJ + C_CC + c]) * bf2f(PROJ[(size_t)(t0 - 1) * NPJ + C_CH + c]);
#pragma unroll 8
    for (int i = 0; i < 32; ++i) { const size_t t = (size_t)(t0 + i);
        const float p2 = bf2f(PROJ[t * NPJ + C_CC + c]) * bf2f(PROJ[t * NPJ + C_CH + c]);
        YCAT[t * DM + 1536 + c] = f2bf(bf2f(PROJ[t * NPJ + C_CB + c]) * (w0 * p0 + w1 * p1 + w2 * p2)); p0 = p1; p1 = p2; }
}

struct Args { const void* in[25]; float* out; unsigned char* ws; int ph_lo, ph_hi; };
__global__ void __launch_bounds__(NWAVES * 64, 2) mk_fwd(Args args) {
    extern __shared__ __attribute__((aligned(16))) unsigned char lds_raw[];
    LAS unsigned char* lds = (LAS unsigned char*)lds_raw;
    volatile LAS unsigned* MISC = (volatile LAS unsigned*)(lds + MISC_OFF);
    const int tid = threadIdx.x, lane = tid & 63, wave = __builtin_amdgcn_readfirstlane(tid >> 6), bid = blockIdx.x, G = gridDim.x;
    unsigned char* ws = args.ws;
    unsigned* ctl = (unsigned*)(ws + WS_CTL);
    for (int u = tid; u < (LDS_BYTES - LDSCTL_OFF) / 4; u += NWAVES * 64) ((LAS unsigned*)(lds + LDSCTL_OFF))[u] = 0u;
    __syncthreads();
    XcdBarrier bar; bar.bar = ctl + CW_BAR; bar.x = 0; bar.st = nullptr;
    if (!MK_SPLIT) bar = xcd_barrier_post(ctl + CW_BAR, MISC + 8);
#define GRID_BAR() do { if (!MK_SPLIT) xcd_barrier(bar); } while (0)
    const int lo = args.ph_lo, hi = args.ph_hi;
#define IN(k) (lo <= (k) && (k) < hi)
#define SEAM(k) do { if (IN(k) && IN((k) + 1)) GRID_BAR(); } while (0)
    const float* x_in = (const float*)args.in[0]; const float* c_in = (const float*)args.in[1]; const int* positions = (const int*)args.in[2];
    const float* ada_w = (const float*)args.in[3]; const float* ada_b = (const float*)args.in[4];
    const float* n_pre_mix = (const float*)args.in[5]; const float* n_post_mix = (const float*)args.in[6]; const float* n_pre_mlp = (const float*)args.in[7]; const float* n_post_mlp = (const float*)args.in[8];
    const float* w_in = (const float*)args.in[9]; const float* w_out = (const float*)args.in[10];
    const float* gdn_conv_w = (const float*)args.in[11]; const float* gdn_a_log = (const float*)args.in[12]; const float* gdn_dt_bias = (const float*)args.in[13]; const float* gdn_norm_w = (const float*)args.in[14];
    const float* ssm_conv_w = (const float*)args.in[15]; const float* ssm_conv_b = (const float*)args.in[16]; const float* ssm_a_log = (const float*)args.in[17]; const float* ssm_dt_bias = (const float*)args.in[18];
    const float* ssm_d = (const float*)args.in[19]; const float* ssm_norm_w = (const float*)args.in[20]; const float* attn_sinks = (const float*)args.in[21]; const float* sc_conv_w = (const float*)args.in[22];
    const float* w_up = (const float*)args.in[23]; const float* w_down = (const float*)args.in[24];
    float* X = args.out;
    float* MOD = (float*)(ctl + CW_MOD); float* RSS = (float*)(ctl + CW_RSS);
    bf16* Hb = (bf16*)(ws + WS_H); bf16* PROJ = (bf16*)(ws + WS_PROJ); bf16* YCAT = (bf16*)(ws + WS_YCAT); float* Y = (float*)(ws + WS_Y); bf16* HID = (bf16*)(ws + WS_HID);
    unsigned char* GIMG = ws + WS_GIMG; float* GU = (float*)(ws + WS_GU); float* GO = (float*)(ws + WS_GO); float* SST = (float*)(ws + WS_SST);
    float* SCD = (float*)(ws + WS_MISC); float* GCD = SCD + 512; f32x2* ROPE = (f32x2*)(ws + WS_ROPE);
    const int gw = bid * NWAVES + wave, NGW = G * NWAVES;

    if (EN(0) && IN(0)) phase_prologue_a(lds, c_in, ada_w, ada_b, MOD, w_in, w_out, w_up, w_down, ws, bid, tid, wave, lane);
    SEAM(0);
    if (EN(1) && IN(1)) {
        rowpass<false, true>(x_in, nullptr, nullptr, nullptr, nullptr, nullptr, n_pre_mix, MOD + 1 * DM, MOD + 0 * DM, Hb, gw, NGW, lane);
        for (int e = bid * 512 + tid; e < SEQ * 32; e += G * 512) { const float ang = (float)positions[e >> 5] * exp2f(-(float)(e & 31) * 0.4152410118609203f); float sn, cs; sincosf(ang, &sn, &cs); ROPE[e] = (f32x2){cs, sn}; }
    }
    SEAM(1);
#pragma unroll 1
    for (int L = 0; L < DEPTH; ++L) {
        const int pb = 2 + 9 * L;
        int tid = threadIdx.x; asm volatile("" : "+v"(tid));
        const int lane = tid & 63, wave = __builtin_amdgcn_readfirstlane(tid >> 6), gw = bid * NWAVES + wave;
        const float* mod = MOD + (size_t)L * 6 * DM;
        if (EN(2) && IN(pb + 0)) { pg8::Gemm g{Hb, (const bf16*)(ws + WS_WIN + L * WIN_L), SEQ, NPJ, DM}; pg8::StaticOrder S; S.init(SEQ, NPJ, G, bid);
            pg8::EpiB<0> E{PROJ, NPJ}; pg8::gemm_phase<pg8::EpiB<0>, pg8::StaticOrder, PG8_ALIGN, PG8_SP2>(lds, g, S, E); }
        SEAM(pb + 0);
        if (IN(pb + 1)) {
            if (EN(3)) for (int u = bid; u < 512; u += G) { const int h = u >> 7, n = u & 127;
                gdn_prep_unit(lds, PROJ, gdn_conv_w + (size_t)L * 4 * 1536, gdn_a_log[L * 4 + h], gdn_dt_bias[L * 4 + h], h, n, GIMG + (size_t)u * IMG_BYTES, GU + (size_t)u * 8192, GCD + u, tid); }
            if (EN(4)) for (int u = bid; u < 512; u += G) { const int c = u >> 3, h = u & 7;
                ssd_step1_unit(lds, PROJ, ssm_conv_w + (size_t)L * 4 * 1024, ssm_conv_b + (size_t)L * 1024, ssm_a_log[L * 8 + h], ssm_dt_bias[L * 8 + h], c, h, SST, SCD, tid); }
        }
        SEAM(pb + 1);
        if (EN(5) && IN(pb + 2)) ssd_scan(SST, SCD, bid, tid);
        SEAM(pb + 2);
        if (IN(pb + 3)) {
            if (bid < 4) { if (EN(6)) gdn_scan(lds, GIMG, GU, GCD, GO, PROJ, gdn_norm_w + (size_t)L * 128, YCAT, bid, tid); }
            else for (int u = bid - 4; u < 1024; u += G - 4) {
                int tid_u = tid; asm volatile("" : "+v"(tid_u));
                if (u < 256) { if (EN(7)) swa_unit(lds, PROJ, ROPE, attn_sinks + L * 8, YCAT, u >> 2, (u >> 1) & 1, u & 1, tid_u); }
                else if (u < 768) { const int v = u - 256; if (EN(8)) ssd_step3_unit(lds, PROJ, ssm_conv_w + (size_t)L * 4 * 1024, ssm_conv_b + (size_t)L * 1024, ssm_a_log + L * 8, ssm_dt_bias + L * 8,
                                                                      ssm_d + L * 8, ssm_norm_w + (size_t)L * 512, SST, YCAT, v >> 3, (v >> 2) & 1, 3 - (v & 3), tid_u); }
                else if (EN(9)) sc_unit(PROJ, sc_conv_w + (size_t)L * 3 * 512, YCAT, u - 768, tid_u);
            }
        }
        SEAM(pb + 3);
        if (EN(10) && IN(pb + 4)) { pg8::Gemm g{YCAT, (const bf16*)(ws + WS_WOUT + L * WOUT_L), SEQ, DM, DM}; pg8::StaticOrder S; S.init(SEQ, DM, G, bid);
            pg8::EpiF32SS E{Y, DM, RSS + (2 * L) * SEQ}; pg8::gemm_phase<pg8::EpiF32SS, pg8::StaticOrder, false, PG8_SP2>(lds, g, S, E); }
        SEAM(pb + 4);
        if (EN(11) && IN(pb + 5)) rowpass<true, true>(L == 0 ? x_in : X, Y, RSS + (2 * L) * SEQ, mod + 2 * DM, n_post_mix + L * DM, X, n_pre_mlp + L * DM, mod + 4 * DM, mod + 3 * DM, Hb, gw, NGW, lane);
        SEAM(pb + 5);
        if (EN(12) && IN(pb + 6)) { pg8::Gemm g{Hb, (const bf16*)(ws + WS_WUP + L * WUP_L), SEQ, HIDN, DM}; pg8::StaticOrder S; S.init(SEQ, HIDN, G, bid);
            pg8::EpiB<2> E{HID, HIDN}; pg8::gemm_phase<pg8::EpiB<2>, pg8::StaticOrder, PG8_ALIGN, PG8_SP2>(lds, g, S, E); }
        SEAM(pb + 6);
        if (EN(13) && IN(pb + 7)) { pg8::Gemm g{HID, (const bf16*)(ws + WS_WDN + L * WDN_L), SEQ, DM, HIDN}; pg8::StaticOrder S; S.init(SEQ, DM, G, bid);
            pg8::EpiF32SS E{Y, DM, RSS + (2 * L + 1) * SEQ}; pg8::gemm_phase<pg8::EpiF32SS, pg8::StaticOrder, false, PG8_SP2>(lds, g, S, E); }
        SEAM(pb + 7);
        if (EN(14) && IN(pb + 8)) {
            if (L + 1 < DEPTH) rowpass<true, true>(X, Y, RSS + (2 * L + 1) * SEQ, mod + 5 * DM, n_post_mlp + L * DM, X, n_pre_mix + (L + 1) * DM, mod + 6 * DM + 1 * DM, mod + 6 * DM + 0 * DM, Hb, gw, NGW, lane);
            else rowpass<true, false>(X, Y, RSS + (2 * L + 1) * SEQ, mod + 5 * DM, n_post_mlp + L * DM, X, nullptr, nullptr, nullptr, nullptr, gw, NGW, lane);
        }
        if (L + 1 < DEPTH) SEAM(pb + 8);
    }
#undef IN
#undef SEAM
#undef GRID_BAR
}

extern "C" void kernel_launch(void* const* d_in, const int* in_sizes, int n_in, void* d_out, int out_size, void* d_ws, size_t ws_size, hipStream_t stream) {
    static int grid = 0;
    if (grid == 0) {
        if (n_in != 25 || out_size != SEQ * DM || ws_size < WS_END) { fprintf(stderr, "kernel_launch: unexpected shapes (n_in %d out %d ws %zu); nothing launched\n", n_in, out_size, ws_size); grid = -1; return; }
        int dev = 0, cus = 0, per_cu = 0;
        if (hipGetDevice(&dev) != hipSuccess || hipDeviceGetAttribute(&cus, hipDeviceAttributeMultiprocessorCount, dev) != hipSuccess) { grid = -1; return; }
        if (hipFuncSetAttribute((const void*)mk_fwd, hipFuncAttributeMaxDynamicSharedMemorySize, LDS_BYTES) != hipSuccess) { fprintf(stderr, "kernel_launch: hipFuncSetAttribute failed\n"); grid = -1; return; }
        if (hipOccupancyMaxActiveBlocksPerMultiprocessor(&per_cu, (const void*)mk_fwd, NWAVES * 64, LDS_BYTES) != hipSuccess || per_cu < 1)
            fprintf(stderr, "kernel_launch: note: occupancy query reports %d workgroups per CU\n", per_cu);
        (void)hipGetLastError();
        grid = cus;
        if (grid != 256) { fprintf(stderr, "kernel_launch: built for 256 CUs, device has %d; nothing launched\n", cus); grid = -1; return; }
    }
    if (grid < 0) return;
    if (hipMemsetAsync((char*)d_ws + WS_CTL, 0, CTL_ZERO_BYTES, stream) != hipSuccess) return;
    Args a{};
    for (int i = 0; i < 25; ++i) a.in[i] = d_in[i];
    a.out = (float*)d_out; a.ws = (unsigned char*)d_ws;
#if MK_SPLIT
    for (int p = 0; p < NPHASES; ++p) { a.ph_lo = p; a.ph_hi = p + 1; hipLaunchKernelGGL(mk_fwd, dim3(grid), dim3(NWAVES * 64), LDS_BYTES, stream, a); }
#else
    a.ph_lo = 0; a.ph_hi = NPHASES;
    hipLaunchKernelGGL(mk_fwd, dim3(grid), dim3(NWAVES * 64), LDS_BYTES, stream, a);
#endif
}
```

```cpp
#include <hip/hip_runtime.h>
#include <cstdio>
#include <cstdint>
namespace pg8 {
#define PG8_LAS __attribute__((address_space(3)))
typedef unsigned short bf16_t;
typedef short bf16x8 __attribute__((ext_vector_type(8)));
typedef float f32x4 __attribute__((ext_vector_type(4)));
typedef unsigned u32x4 __attribute__((ext_vector_type(4)));
constexpr int BM = 256, BK = 64, HALF = 128, HTB = HALF * BK * 2  , STAGE_BYTES = 8 * HTB, NXCD = 8, WGM = 8;

__host__ __device__ __forceinline__ int lds_byte(int r, int c) { const int st = (r >> 4) * 2 + (c >> 5), rr = r & 15, cc = c & 31, ob = rr * 64 + cc * 2; return st * 1024 + (ob ^ (((ob >> 9) & 1) << 5)); }
__host__ __device__ __forceinline__ void stage_rc(int b, int& R, int& C) { const int st = b / 1024, sb = b % 1024, swz = sb ^ (((sb >> 9) & 1) << 5); R = (st >> 1) * 16 + swz / 64; C = (st & 1) * 32 + (swz % 64) / 2; }
__host__ __device__ __forceinline__ int perm32(int rho) { const int n = rho >> 4, i = rho & 15; return 8 * (i >> 2) + 4 * n + (i & 3); }

struct Unit { int pm, pn; };
struct Gemm { const bf16_t* A; const bf16_t* Bt; int M, N, K; };

struct StaticOrder {
    int nM, nN, nwg, G, c;
    __host__ __device__ void init(int M, int N, int G_, int c_) { nM = M / BM; nN = N / BM; nwg = nM * nN; G = G_; c = c_; }
    __host__ __device__ bool next(int i, Unit& u) const {
        const long L = (long)i * G + c; if (L >= nwg) return false;
        int wgid = (int)L; { const int q = nwg / NXCD, r = nwg % NXCD, xcd = wgid % NXCD, off = wgid / NXCD; wgid = (xcd < r ? xcd * (q + 1) : r * (q + 1) + (xcd - r) * q) + off; }
        const int nig = WGM * nN, gid = wgid / nig, fm = gid * WGM, gsz = (nM - fm) < WGM ? (nM - fm) : WGM;
        u.pm = fm + ((wgid % nig) % gsz); u.pn = (wgid % nig) / gsz; return true;
    }
    __device__ __forceinline__ void a_ready(const Unit&) const {}
    __device__ __forceinline__ void done(const Unit&) const {}
};

__device__ __forceinline__ unsigned cvt_pk_bf16(float lo, float hi) { unsigned r; asm volatile("v_cvt_pk_bf16_f32 %0, %1, %2" : "=v"(r) : "v"(lo), "v"(hi)); return r; }
typedef float f32x2 __attribute__((ext_vector_type(2)));
__device__ __forceinline__ f32x2 gelu_pk(f32x2 v) {
    const f32x2 av = __builtin_elementwise_abs(v), d = av * 0.2316418882f + 1.0f;
    f32x2 t; t.x = __builtin_amdgcn_rcpf(d.x); t.y = __builtin_amdgcn_rcpf(d.y);
    f32x2 q = t * 0.5307027145f + (-0.7265760135f); q = q * t + 0.7107068705f; q = q * t + (-0.142248368f); q = q * t + 0.127414796f; q = q * t;
    const f32x2 s = (v * v) * (-0.72134752044f);
    f32x2 e; e.x = __builtin_amdgcn_exp2f(s.x); e.y = __builtin_amdgcn_exp2f(s.y);
    const f32x2 m = v * (q * e), r = v - m;
    f32x2 o; o.x = v.x < 0.f ? m.x : r.x; o.y = v.y < 0.f ? m.y : r.y; return o;
}

template <int ACT  > struct EpiBf16 {
    static constexpr bool PERM = true, AFTER_DRAIN = false; static_assert(ACT == 0 || ACT == 1, "EpiBf16: ACT is 0 (none) or 1 (gelu_pk)");
    bf16_t* O; int ldc; const float* bias; int split_cols; size_t split_stride; float scale0;
    __device__ __forceinline__ void operator()(const f32x4 (&acc)[2][2][4][2], const Unit& u, int wr, int wc, int fr, int fq) const {
        const int row0 = u.pm * BM + wr * 64 + fr; int colt = u.pn * BM; bf16_t* base = O;
        float sc = 1.f; if (split_cols) { const int t = colt / split_cols; base += (size_t)t * split_stride; colt -= t * split_cols; if (t == 0) sc = scale0; }
        const int col0 = colt + wc * 32 + 8 * fq, bcol0 = u.pn * BM + wc * 32 + 8 * fq;
        f32x4 bv[2][2];
#pragma unroll
        for (int bj = 0; bj < 2; ++bj)
#pragma unroll
            for (int n = 0; n < 2; ++n) bv[bj][n] = bias ? *(const f32x4*)(bias + bcol0 + bj * HALF + 4 * n) : (f32x4){0.f, 0.f, 0.f, 0.f};
#pragma unroll
        for (int ai = 0; ai < 2; ++ai)
#pragma unroll
            for (int m = 0; m < 4; ++m) { bf16_t* rowp = base + (size_t)(row0 + ai * HALF + m * 16) * ldc + col0;
#pragma unroll
                for (int bj = 0; bj < 2; ++bj) { f32x4 v0 = acc[ai][bj][m][0] + bv[bj][0], v1 = acc[ai][bj][m][1] + bv[bj][1];
                    if (ACT == 1) { f32x2 a = gelu_pk((f32x2){v0[0], v0[1]}), b = gelu_pk((f32x2){v0[2], v0[3]}), c = gelu_pk((f32x2){v1[0], v1[1]}), d = gelu_pk((f32x2){v1[2], v1[3]});
                        v0 = (f32x4){a.x, a.y, b.x, b.y}; v1 = (f32x4){c.x, c.y, d.x, d.y}; }
                    v0 = v0 * sc; v1 = v1 * sc; u32x4 w; w.x = cvt_pk_bf16(v0[0], v0[1]); w.y = cvt_pk_bf16(v0[2], v0[3]); w.z = cvt_pk_bf16(v1[0], v1[1]); w.w = cvt_pk_bf16(v1[2], v1[3]);
                    *(u32x4*)(rowp + bj * HALF) = w; } }
    }
};

struct PanelStats {
    unsigned* xbuf;
    unsigned* cnt;
    unsigned* tmo;
    int ntn; float eps;
    unsigned code;
    __device__ __forceinline__ bool run(const f32x4 (&v)[2][2][4][2], const Unit& u, int wr, int wc, int fr, int fq, PG8_LAS unsigned char* lds, int wid, int lane) const {
        typedef float f32x2v __attribute__((ext_vector_type(2)));
        PG8_LAS f32x2v* P = (PG8_LAS f32x2v*)lds;
        PG8_LAS f32x2v* S = (PG8_LAS f32x2v*)(lds + 8192);
        PG8_LAS unsigned* flag = (PG8_LAS unsigned*)(lds + 8192 + 2048);
#pragma unroll
        for (int ai = 0; ai < 2; ++ai)
#pragma unroll
            for (int m = 0; m < 4; ++m) {
                float s = 0.f;
#pragma unroll
                for (int bj = 0; bj < 2; ++bj)
#pragma unroll
                    for (int n = 0; n < 2; ++n) { const f32x4 x = v[ai][bj][m][n]; s += (x[0] + x[1]) + (x[2] + x[3]); }
                s += __shfl_xor(s, 16); s += __shfl_xor(s, 32);
                const float mw = s * (1.0f / 64.0f); float q = 0.f;
#pragma unroll
                for (int bj = 0; bj < 2; ++bj)
#pragma unroll
                    for (int n = 0; n < 2; ++n) { const f32x4 d = v[ai][bj][m][n] - mw; q += (d[0] * d[0] + d[1] * d[1]) + (d[2] * d[2] + d[3] * d[3]); }
                q += __shfl_xor(q, 16); q += __shfl_xor(q, 32);
                if (fq == 0) P[(ai * HALF + wr * 64 + m * 16 + fr) * 4 + wc] = (f32x2v){mw, q};
            }
        asm volatile("s_waitcnt lgkmcnt(0)" ::: "memory"); __builtin_amdgcn_s_barrier(); asm volatile("" ::: "memory");
#if defined(BROKEN_EXCHANGE_NO_WAIT)
#warning BROKEN CONTROL BUILD: the row-statistics exchange does not wait; results are wrong by design
        if (blockIdx.x >= 64) { const long long t0_ = clock64(); while (clock64() - t0_ < 60000) __builtin_amdgcn_s_sleep(8); }
#endif
        const int row = wid * 32 + (lane & 31);
        if (lane < 32) {
            const f32x2v a = P[row * 4 + 0], b = P[row * 4 + 1], c = P[row * 4 + 2], d = P[row * 4 + 3];
            const float mt = (a.x + b.x + c.x + d.x) * 0.25f;
            const float da = a.x - mt, db = b.x - mt, dc = c.x - mt, dd = d.x - mt;
            const float m2 = (a.y + b.y) + (c.y + d.y) + 64.0f * ((da * da + db * db) + (dc * dc + dd * dd));
            unsigned long long* slot = (unsigned long long*)xbuf + ((size_t)(u.pm * BM + row) * 4 + u.pn);
            __hip_atomic_store(slot, ((unsigned long long)__float_as_uint(m2) << 32) | __float_as_uint(mt), __ATOMIC_RELAXED, __HIP_MEMORY_SCOPE_AGENT);
        }
        asm volatile("s_waitcnt vmcnt(0)" ::: "memory");
        if (lane == 0) __hip_atomic_fetch_add(cnt + 64 * u.pm, 1u, __ATOMIC_RELAXED, __HIP_MEMORY_SCOPE_AGENT);
        if (wid == 0) {
            bool dead = false; const unsigned long long t0 = __builtin_amdgcn_s_memrealtime(); const unsigned want = 8u * (unsigned)ntn;
            for (;;) {
#if defined(BROKEN_EXCHANGE_NO_WAIT)
                break;
#endif
                if ((unsigned)__builtin_amdgcn_readfirstlane(__hip_atomic_load(cnt + 64 * u.pm, __ATOMIC_RELAXED, __HIP_MEMORY_SCOPE_AGENT)) >= want) break;
                if (__builtin_amdgcn_s_memrealtime() - t0 > 2000000ull) {
                    if (lane == 0) { unsigned expect = 0u; __hip_atomic_compare_exchange_strong(tmo + 1, &expect, code | (unsigned)(u.pm & 0xff), __ATOMIC_RELAXED, __ATOMIC_RELAXED, __HIP_MEMORY_SCOPE_AGENT);
                                     __hip_atomic_store(tmo, 1u, __ATOMIC_RELAXED, __HIP_MEMORY_SCOPE_AGENT); }
                    dead = true; break; }
                __builtin_amdgcn_s_sleep(2);
            }
            __builtin_amdgcn_fence(__ATOMIC_ACQUIRE, "agent");
            if (lane == 0) flag[0] = dead ? 1u : 0u;
        }
        asm volatile("s_waitcnt vmcnt(0) lgkmcnt(0)" ::: "memory"); __builtin_amdgcn_s_barrier(); asm volatile("" ::: "memory");
        const bool bad = flag[0] != 0u;
        if (lane < 32) {
            const unsigned long long* slot = (const unsigned long long*)xbuf + (size_t)(u.pm * BM + row) * 4; float mt[4], m2[4]; float ms = 0.f;
#pragma unroll
            for (int t = 0; t < 4; ++t) { if (t < ntn) { const unsigned long long w = __hip_atomic_load(slot + t, __ATOMIC_RELAXED, __HIP_MEMORY_SCOPE_AGENT); mt[t] = __uint_as_float((unsigned)w); m2[t] = __uint_as_float((unsigned)(w >> 32)); } else { mt[t] = 0.f; m2[t] = 0.f; } ms += mt[t]; }
            const float mean = ms / (float)ntn; float q = 0.f;
#pragma unroll
            for (int t = 0; t < 4; ++t) if (t < ntn) { const float dm = mt[t] - mean; q += m2[t] + 256.0f * dm * dm; }
            S[row] = (f32x2v){mean, 1.0f / sqrtf(q / (256.0f * (float)ntn) + eps)};
        }
        asm volatile("s_waitcnt lgkmcnt(0)" ::: "memory"); __builtin_amdgcn_s_barrier(); asm volatile("" ::: "memory");
        return bad;
    }
};
struct EpiLnRes {
    static constexpr bool PERM = false, AFTER_DRAIN = true;
    const float* base; float* out; int ldc; const float* bias; PanelStats st; unsigned poison;
    __device__ __forceinline__ void fused(f32x4 (&acc)[2][2][4][2], const Unit& u, int wr, int wc, int fr, int fq, PG8_LAS unsigned char* lds, int wid, int lane) const {
        typedef float f32x2v __attribute__((ext_vector_type(2)));
        const PG8_LAS f32x2v* S = (const PG8_LAS f32x2v*)(lds + 8192);
        const int col0 = u.pn * BM + wc * 32 + 4 * fq;
#pragma unroll
        for (int bj = 0; bj < 2; ++bj)
#pragma unroll
            for (int n = 0; n < 2; ++n) { const f32x4 bv = bias ? *(const f32x4*)(bias + col0 + bj * HALF + n * 16) : (f32x4){0.f, 0.f, 0.f, 0.f};
#pragma unroll
                for (int ai = 0; ai < 2; ++ai)
#pragma unroll
                    for (int m = 0; m < 4; ++m) acc[ai][bj][m][n] += bv; }
        f32x4 pre[4][2][2];
#pragma unroll
        for (int m = 0; m < 4; ++m) { const size_t off = (size_t)(u.pm * BM + wr * 64 + m * 16 + fr) * ldc + col0;
#pragma unroll
            for (int bj = 0; bj < 2; ++bj)
#pragma unroll
                for (int n = 0; n < 2; ++n) pre[m][bj][n] = *(const f32x4*)(base + off + bj * HALF + n * 16); }
        const bool bad = st.run(acc, u, wr, wc, fr, fq, lds, wid, lane) || poison != 0u;
        const float qnan = __builtin_nanf("");
#pragma unroll
        for (int ai = 0; ai < 2; ++ai)
#pragma unroll
            for (int m = 0; m < 4; ++m) { const int r = ai * HALF + wr * 64 + m * 16 + fr; const f32x2v sr = S[r]; const size_t off = (size_t)(u.pm * BM + r) * ldc + col0;
#pragma unroll
                for (int bj = 0; bj < 2; ++bj)
#pragma unroll
                    for (int n = 0; n < 2; ++n) { const f32x4 bs = ai == 0 ? pre[m][bj][n] : *(const f32x4*)(base + off + bj * HALF + n * 16); f32x4 o = bs + (acc[ai][bj][m][n] - sr.x) * sr.y;
                        if (bad) o = (f32x4){qnan, qnan, qnan, qnan}; *(f32x4*)(out + off + bj * HALF + n * 16) = o; }
                if (m & 1) asm volatile("" ::: "memory"); }
    }
};
struct EpiLnResLn {
    static constexpr bool PERM = false, AFTER_DRAIN = true;
    const float* base; float* out; bf16_t* xn; int ldc; const float* bias; PanelStats st1, st2; unsigned poison;
    __device__ __forceinline__ void fused(f32x4 (&acc)[2][2][4][2], const Unit& u, int wr, int wc, int fr, int fq, PG8_LAS unsigned char* lds, int wid, int lane) const {
        typedef float f32x2v __attribute__((ext_vector_type(2))); typedef unsigned u32x2v __attribute__((ext_vector_type(2)));
        const PG8_LAS f32x2v* S = (const PG8_LAS f32x2v*)(lds + 8192);
        const int col0 = u.pn * BM + wc * 32 + 4 * fq;
#pragma unroll
        for (int bj = 0; bj < 2; ++bj)
#pragma unroll
            for (int n = 0; n < 2; ++n) { const f32x4 bv = bias ? *(const f32x4*)(bias + col0 + bj * HALF + n * 16) : (f32x4){0.f, 0.f, 0.f, 0.f};
#pragma unroll
                for (int ai = 0; ai < 2; ++ai)
#pragma unroll
                    for (int m = 0; m < 4; ++m) acc[ai][bj][m][n] += bv; }
        bool bad = st1.run(acc, u, wr, wc, fr, fq, lds, wid, lane) || poison != 0u;
        const float qnan = __builtin_nanf("");
#pragma unroll
        for (int ai = 0; ai < 2; ++ai)
#pragma unroll
            for (int m = 0; m < 4; ++m) { const int r = ai * HALF + wr * 64 + m * 16 + fr; const f32x2v sr = S[r]; const size_t off = (size_t)(u.pm * BM + r) * ldc + col0;
#pragma unroll
                for (int bj = 0; bj < 2; ++bj)
#pragma unroll
                    for (int n = 0; n < 2; ++n) { const f32x4 bs = *(const f32x4*)(base + off + bj * HALF + n * 16); acc[ai][bj][m][n] = bs + (acc[ai][bj][m][n] - sr.x) * sr.y; }
                asm volatile("" : "+v"(acc[ai][0][m][0]), "+v"(acc[ai][0][m][1]), "+v"(acc[ai][1][m][0]), "+v"(acc[ai][1][m][1]));
                if (m & 1) asm volatile("" ::: "memory"); }
        const bool bad1 = bad;
        bad = st2.run(acc, u, wr, wc, fr, fq, lds, wid, lane) || bad;
#pragma unroll
        for (int ai = 0; ai < 2; ++ai)
#pragma unroll
            for (int m = 0; m < 4; ++m) { const int r = ai * HALF + wr * 64 + m * 16 + fr; const f32x2v sr = S[r]; const size_t off = (size_t)(u.pm * BM + r) * ldc + col0;
#pragma unroll
                for (int bj = 0; bj < 2; ++bj)
#pragma unroll
                    for (int n = 0; n < 2; ++n) { const f32x4 x1 = acc[ai][bj][m][n]; *(f32x4*)(out + off + bj * HALF + n * 16) = bad1 ? (f32x4){qnan, qnan, qnan, qnan} : x1;
                        const f32x4 o = (x1 - sr.x) * sr.y; u32x2v w; w.x = cvt_pk_bf16(o[0], o[1]); w.y = cvt_pk_bf16(o[2], o[3]);
                        if (bad) { w.x = 0x7fc07fc0u; w.y = 0x7fc07fc0u; } *(u32x2v*)(xn + off + bj * HALF + n * 16) = w; }
                asm volatile("" ::: "memory"); }
    }
};

template <class Epi, class Sched, bool ALIGN_EPI = false, bool SP2 = false>
__device__ __forceinline__ void gemm_phase(PG8_LAS unsigned char* lds, const Gemm g, const Sched& S, const Epi& E, const int tid_in) {
    int tid_ = tid_in; asm volatile("" : "+v"(tid_));
    const int tid = tid_, wid = __builtin_amdgcn_readfirstlane(tid >> 6), lane = tid & 63, wr = wid >> 2, wc = wid & 3, fr = lane & 15, fq = lane >> 4;
    const int K = g.K, nt = K / BK;
    unsigned voffA[2], voffB[2];
#pragma unroll
    for (int i = 0; i < 2; ++i) { int R, C; stage_rc(tid * 16 + i * 8192, R, C); const int Rb = Epi::PERM ? ((R & ~31) + perm32(R & 31)) : R;
        voffA[i] = (unsigned)(R * K + C) * 2u; voffB[i] = (unsigned)(Rb * K + C) * 2u; }
    const size_t kstep = (size_t)(BK * 2);
    const size_t hstep = (size_t)HALF * K * 2;
    const size_t tstep = 2 * hstep;
    const unsigned ldsw = (unsigned)wid * 1024u;
    const int aoff = lds_byte(wr * 64 + fr, fq * 8), boff = lds_byte(wc * 32 + fr, fq * 8);
#define PG8_SA(b, h) (((b) * 2 + (h)) * HTB)
#define PG8_SB(b, h) ((4 + (b) * 2 + (h)) * HTB)
#define PG8_STAGE(bufoff, gbase, voff) do { _Pragma("unroll") for (int _i = 0; _i < 2; ++_i) \
        __builtin_amdgcn_global_load_lds((const unsigned*)((const char*)(gbase) + (voff)[_i]), (PG8_LAS unsigned*)(lds + (bufoff) + ldsw + _i * 8192), 16, 0, 0); } while (0)
#define PG8_LDA(dst, b, h) do { _Pragma("unroll") for (int m = 0; m < 4; ++m) _Pragma("unroll") for (int k = 0; k < 2; ++k) dst[m][k] = *(const PG8_LAS bf16x8*)(lds + PG8_SA(b, h) + aoff + m * 2048 + k * 1024); } while (0)
#define PG8_LDB(dst, b, h) do { _Pragma("unroll") for (int n = 0; n < 2; ++n) _Pragma("unroll") for (int k = 0; k < 2; ++k) dst[n][k] = *(const PG8_LAS bf16x8*)(lds + PG8_SB(b, h) + boff + n * 2048 + k * 1024); } while (0)
#define PG8_MMA(ai, bj, At, Bt) do { __builtin_amdgcn_s_setprio(1); _Pragma("unroll") for (int m = 0; m < 4; ++m) _Pragma("unroll") for (int n = 0; n < 2; ++n) _Pragma("unroll") for (int k = 0; k < 2; ++k) \
        acc[ai][bj][m][n] = __builtin_amdgcn_mfma_f32_16x16x32_bf16(Bt[n][k], At[m][k], acc[ai][bj][m][n], 0, 0, 0); __builtin_amdgcn_s_setprio(0); } while (0)
#define PG8_WAIT_V(n) asm volatile("s_waitcnt vmcnt(" #n ")" ::: "memory")
#define PG8_WAIT_L(n) asm volatile("s_waitcnt lgkmcnt(" #n ")" ::: "memory")
#define PG8_BAR __builtin_amdgcn_s_barrier()
#define PG8_SCHED __builtin_amdgcn_sched_barrier(0)
    Unit cur, nxt; int ui = 0;
    if (!S.next(0, cur)) return;
    f32x4 acc[2][2][4][2];
#pragma unroll
    for (int a = 0; a < 2; ++a)
#pragma unroll
        for (int b = 0; b < 2; ++b)
#pragma unroll
            for (int m = 0; m < 4; ++m)
#pragma unroll
                for (int n = 0; n < 2; ++n) acc[a][b][m][n] = (f32x4){0.f, 0.f, 0.f, 0.f};
    bf16x8 At[4][2], B0[2][2], B1[2][2];
    const char* cA = (const char*)g.A + (size_t)cur.pm * tstep; const char* cB = (const char*)g.Bt + (size_t)cur.pn * tstep;
    S.a_ready(cur);
    if constexpr (SP2) {
        PG8_STAGE(PG8_SB(0, 0), cB, voffB); PG8_STAGE(PG8_SB(0, 1), cB + hstep, voffB); PG8_STAGE(PG8_SA(0, 0), cA, voffA); PG8_STAGE(PG8_SA(0, 1), cA + hstep, voffA);
        if (wr == 1) PG8_BAR;
        PG8_WAIT_V(2); PG8_BAR;
        PG8_STAGE(PG8_SB(1, 0), cB + kstep, voffB); PG8_STAGE(PG8_SA(1, 0), cA + kstep, voffA); PG8_STAGE(PG8_SB(1, 1), cB + hstep + kstep, voffB);
        PG8_WAIT_V(6); PG8_BAR;
    } else {
        PG8_STAGE(PG8_SB(0, 0), cB, voffB); PG8_STAGE(PG8_SA(0, 0), cA, voffA); PG8_STAGE(PG8_SB(0, 1), cB + hstep, voffB); PG8_STAGE(PG8_SA(0, 1), cA + hstep, voffA);
        if (wr == 1) PG8_BAR;
        PG8_WAIT_V(4); PG8_BAR;
        PG8_STAGE(PG8_SB(1, 0), cB + kstep, voffB); PG8_STAGE(PG8_SA(1, 0), cA + kstep, voffA); PG8_STAGE(PG8_SB(1, 1), cB + hstep + kstep, voffB);
        PG8_WAIT_V(6); PG8_BAR;
    }
    for (;;) {
        const bool has_next = S.next(ui + 1, nxt);
        const char* nA = has_next ? (const char*)g.A + (size_t)nxt.pm * tstep : cA; const char* nB = has_next ? (const char*)g.Bt + (size_t)nxt.pn * tstep : cB;
        for (int t = 0; t < nt; t += 2) {
            const bool last = (t == nt - 2);
            const char* a1 = cA + (size_t)(t + 1) * kstep;
            const char* a2 = last ? nA : cA + (size_t)(t + 2) * kstep; const char* b2 = last ? nB : cB + (size_t)(t + 2) * kstep;
            const char* a3 = a2 + kstep; const char* b3 = b2 + kstep;
            if (last && has_next) S.a_ready(nxt);
            if constexpr (SP2) {
            PG8_LDB(B0, 0, 0); PG8_LDB(B1, 0, 1); PG8_SCHED; PG8_LDA(At, 0, 0); PG8_STAGE(PG8_SA(1, 1), a1 + hstep, voffA);
            PG8_WAIT_V(8); PG8_WAIT_L(0); PG8_BAR; PG8_MMA(0, 0, At, B0); PG8_MMA(0, 1, At, B1); PG8_BAR; PG8_SCHED;
            PG8_LDA(At, 0, 1); PG8_STAGE(PG8_SB(0, 0), b2, voffB); PG8_STAGE(PG8_SB(0, 1), b2 + hstep, voffB); PG8_STAGE(PG8_SA(0, 0), a2, voffA);
            PG8_WAIT_V(8); PG8_WAIT_L(0); PG8_BAR; PG8_MMA(1, 0, At, B0); PG8_MMA(1, 1, At, B1); PG8_BAR; PG8_SCHED;
            PG8_LDB(B0, 1, 0); PG8_LDB(B1, 1, 1); PG8_SCHED; PG8_LDA(At, 1, 0); PG8_STAGE(PG8_SA(0, 1), a2 + hstep, voffA);
            PG8_WAIT_V(8); PG8_WAIT_L(0); PG8_BAR; PG8_MMA(0, 0, At, B0); PG8_MMA(0, 1, At, B1); PG8_BAR; PG8_SCHED;
            PG8_LDA(At, 1, 1); PG8_STAGE(PG8_SB(1, 0), b3, voffB); PG8_STAGE(PG8_SB(1, 1), b3 + hstep, voffB); PG8_STAGE(PG8_SA(1, 0), a3, voffA);
            PG8_WAIT_V(8); PG8_WAIT_L(0); PG8_BAR; PG8_MMA(1, 0, At, B0); PG8_MMA(1, 1, At, B1); PG8_BAR; PG8_SCHED;
            } else {
            PG8_LDB(B0, 0, 0); PG8_SCHED; PG8_LDA(At, 0, 0); PG8_STAGE(PG8_SA(1, 1), a1 + hstep, voffA);
            PG8_WAIT_L(8); PG8_BAR; PG8_WAIT_L(0); PG8_MMA(0, 0, At, B0); PG8_BAR; PG8_SCHED;
            PG8_LDB(B1, 0, 1); PG8_STAGE(PG8_SB(0, 0), b2, voffB);
            PG8_BAR; PG8_WAIT_L(0); PG8_MMA(0, 1, At, B1); PG8_BAR;
            PG8_LDA(At, 0, 1); PG8_STAGE(PG8_SA(0, 0), a2, voffA);
            PG8_BAR; PG8_WAIT_L(0); PG8_MMA(1, 0, At, B0); PG8_BAR; PG8_SCHED;
            PG8_STAGE(PG8_SB(0, 1), b2 + hstep, voffB);
            PG8_WAIT_V(6); PG8_BAR; PG8_MMA(1, 1, At, B1); PG8_BAR;
            PG8_LDB(B0, 1, 0); PG8_SCHED; PG8_LDA(At, 1, 0); PG8_STAGE(PG8_SA(0, 1), a2 + hstep, voffA);
            PG8_WAIT_L(8); PG8_BAR; PG8_WAIT_L(0); PG8_MMA(0, 0, At, B0); PG8_BAR; PG8_SCHED;
            PG8_LDB(B1, 1, 1); PG8_STAGE(PG8_SB(1, 0), b3, voffB);
            PG8_BAR; PG8_WAIT_L(0); PG8_MMA(0, 1, At, B1); PG8_BAR;
            PG8_LDA(At, 1, 1); PG8_STAGE(PG8_SA(1, 0), a3, voffA);
            PG8_BAR; PG8_WAIT_L(0); PG8_MMA(1, 0, At, B0); PG8_BAR; PG8_SCHED;
            PG8_STAGE(PG8_SB(1, 1), b3 + hstep, voffB);
            PG8_WAIT_V(6); PG8_BAR; PG8_MMA(1, 1, At, B1); PG8_BAR;
            }
        }
        if constexpr (ALIGN_EPI) { if (wr == 0) PG8_BAR; }
        if constexpr (!Epi::AFTER_DRAIN) { E(acc, cur, wr, wc, fr, fq); S.done(cur); }
        if (!has_next) break;
#pragma unroll
        for (int a = 0; a < 2; ++a)
#pragma unroll
            for (int b = 0; b < 2; ++b)
#pragma unroll
                for (int m = 0; m < 4; ++m)
#pragma unroll
                    for (int n = 0; n < 2; ++n) acc[a][b][m][n] = (f32x4){0.f, 0.f, 0.f, 0.f};
        cur = nxt; cA = nA; cB = nB; ++ui;
        if constexpr (ALIGN_EPI) { if (wr == 1) PG8_BAR; }
    }
    PG8_WAIT_V(0);
    if constexpr (!ALIGN_EPI) { if (wr == 0) PG8_BAR; }
    PG8_BAR;
    if constexpr (Epi::AFTER_DRAIN) { E.fused(acc, cur, wr, wc, fr, fq, lds, wid, lane); S.done(cur); }
#undef PG8_SA
#undef PG8_SB
#undef PG8_STAGE
#undef PG8_LDA
#undef PG8_LDB
#undef PG8_MMA
#undef PG8_WAIT_V
#undef PG8_WAIT_L
#undef PG8_BAR
#undef PG8_SCHED
}
}

#ifndef PG8_SP2
#define PG8_SP2 true
#endif
#ifndef PG8_ALIGN
#define PG8_ALIGN true
#endif
#ifndef MK_SPLIT
#define MK_SPLIT 0
#endif
constexpr int NWAVES = 8, NPHASES = 22;
#ifndef MK_EN
#define MK_EN 0xFFFFFFFFu
#endif
#define EN(k) ((MK_EN >> (k)) & 1u)
#ifndef MK_GHOST
#define MK_GHOST 0
#endif
#ifndef MK_REP
#define MK_REP 0u
#endif
#define REPS(k) (1 + (int)((MK_REP >> (k)) & 1u))
constexpr int SEQ = 8192, DM = 2048, GW = 512, INW = 5904, NPJ = 6144, HIDN = 8192, DEPTH = 2;
constexpr float EPS = 1e-6f;
constexpr int C_GQ = 0, C_GK = 512, C_GV = 1024, C_GZ = 1536, C_SZ = 2048, C_SX = 2560, C_SB = 3072, C_SC = 3328, C_AQ = 3584, C_AK = 4096, C_AV = 4224,
              C_CB = 4352, C_CC = 4864, C_CH = 5376, C_GB = 5888, C_GA = 5892, C_SDT = 5896;
constexpr size_t MiB = 1u << 20;
constexpr size_t WS_CTL = 0, CTL_ZERO_BYTES = 1 * MiB;
constexpr size_t WS_WIN = 2 * MiB, WIN_L = (size_t)NPJ * DM * 2;
constexpr size_t WS_WOUT = 50 * MiB, WOUT_L = (size_t)DM * DM * 2;
constexpr size_t WS_WUP = 66 * MiB, WUP_L = (size_t)HIDN * DM * 2;
constexpr size_t WS_WDN = 130 * MiB, WDN_L = WUP_L;
constexpr size_t WS_H = 194 * MiB, WS_PROJ = 226 * MiB, WS_YCAT = 322 * MiB, WS_Y = 354 * MiB, WS_HID = 418 * MiB;
constexpr size_t WS_GIMG = 546 * MiB, WS_GU = 577 * MiB, WS_GO = 593 * MiB, WS_SST = 609 * MiB, WS_MISC = 625 * MiB, WS_ROPE = 626 * MiB, WS_END = 628 * MiB;
constexpr int CW_BAR = 4096, CW_MOD = 16384, CW_RSS = 65536;
constexpr int IMG_W = 0, IMG_Q = 17408, IMG_K = 34816, IMG_A = 53248, IMG_BYTES = 62464;
constexpr int LDS_BYTES = 163840, LDSCTL_OFF = LDS_BYTES - 512, MISC_OFF = LDSCTL_OFF + 320;

#define LAS __attribute__((address_space(3)))
typedef unsigned short bf16;
typedef float f32x4 __attribute__((ext_vector_type(4)));
typedef float f32x2 __attribute__((ext_vector_type(2)));
typedef float f32x8 __attribute__((ext_vector_type(8)));
typedef float f32x16 __attribute__((ext_vector_type(16)));
typedef short bf16x8 __attribute__((ext_vector_type(8)));
typedef unsigned u32x4 __attribute__((ext_vector_type(4)));
typedef unsigned u32x2 __attribute__((ext_vector_type(2)));
typedef __bf16 bfv8 __attribute__((ext_vector_type(8)));
typedef __bf16 bfv2 __attribute__((ext_vector_type(2)));
#define LDS_WAIT() asm volatile("s_waitcnt lgkmcnt(0)" ::: "memory")
#define VM_WAIT() asm volatile("s_waitcnt vmcnt(0)" ::: "memory")
__device__ __forceinline__ float bf2f(unsigned short u) { return __uint_as_float((unsigned)u << 16); }
__device__ __forceinline__ unsigned short f2bf(float f) { return __builtin_bit_cast(unsigned short, (__bf16)f); }
__device__ __forceinline__ unsigned pk2(float lo, float hi) { f32x2 t = {lo, hi}; return __builtin_bit_cast(unsigned, __builtin_convertvector(t, bfv2)); }
__device__ __forceinline__ float bflo(unsigned w) { return __uint_as_float(w << 16); }
__device__ __forceinline__ float bfhi(unsigned w) { return __uint_as_float(w & 0xffff0000u); }
__device__ __forceinline__ float silu_f(float x) { return x * __builtin_amdgcn_rcpf(1.f + __expf(-x)); }
__device__ __forceinline__ float sigmoid_f(float x) { return __builtin_amdgcn_rcpf(1.f + __expf(-x)); }
__device__ __forceinline__ float softplus_f(float x) { return x > 20.f ? x : log1pf(__expf(x)); }
__device__ __forceinline__ float wave_sum(float v) {
#pragma unroll
    for (int o = 1; o < 64; o <<= 1) v += __shfl_xor(v, o);
    return v;
}
__device__ __forceinline__ int permk(int k) { const int q = (k >> 2) & 3; return (k & ~12) | ((((q & 1) << 1) | (q >> 1)) << 2); }
__device__ __forceinline__ int crow(int reg, int h) { return (reg & 3) + 8 * (reg >> 2) + 4 * h; }

#define XB_TMO      128
#define XB_XCNT(j)  (256  + 64 * (j))
#define XB_XSUB(j)  (1280 + 64 * (j))
#define XB_XGEN(j)  (2304 + 64 * (j))
#define XB_TOP      3328
#define XB_TOPGEN   3392
#define XCD_BAR_WORDS 3456
#define XB_SPIN_CAP (1u << 18)

__device__ __forceinline__ unsigned xb_ld(unsigned* p)              { return __hip_atomic_load(p, __ATOMIC_RELAXED, __HIP_MEMORY_SCOPE_AGENT); }
__device__ __forceinline__ unsigned xb_add(unsigned* p, unsigned v) { return __hip_atomic_fetch_add(p, v, __ATOMIC_RELAXED, __HIP_MEMORY_SCOPE_AGENT); }
__device__ __forceinline__ unsigned xb_xcc_id() { return (unsigned)__builtin_amdgcn_s_getreg((3 << 11) | 20) & 0xFu; }
#define XB_SPIN(cond, bar) do { unsigned _sp = 0; while (cond) { __builtin_amdgcn_s_sleep(1); \
    if ((++_sp & 255u) == 0u) { if (xb_ld(&(bar)[XB_TMO])) break; if (_sp > XB_SPIN_CAP) { atomicAdd(&(bar)[XB_TMO], 1u); break; } } } } while (0)

struct XcdBarrier {
    unsigned* bar; unsigned x;
    volatile LAS unsigned* st;
};

__device__ __forceinline__ XcdBarrier xcd_barrier_post(unsigned* bar, volatile LAS unsigned* st, const bool thread0) {
    XcdBarrier b; b.bar = bar; b.x = xb_xcc_id(); b.st = st;
    if (thread0) (void)xb_add(&bar[XB_XCNT(b.x)], 1u);
    return b;
}
__device__ __forceinline__ void xcd_barrier_complete(unsigned* bar, unsigned x, unsigned& nloc, unsigned& nx) {
    const unsigned G = gridDim.x * gridDim.y * gridDim.z;
    unsigned sum, cnt, mine, sp = 0u;
    for (;;) {
        sum = 0u; cnt = 0u; mine = 0u;
#pragma unroll
        for (unsigned j = 0; j < 16; ++j) { const unsigned c = xb_ld(&bar[XB_XCNT(j)]); sum += c; cnt += (c > 0u) ? 1u : 0u; mine = (j == x) ? c : mine; }
        if (sum == G) break;
        __builtin_amdgcn_s_sleep(1);
        if ((++sp & 255u) == 0u) { if (xb_ld(&bar[XB_TMO])) break; if (sp > XB_SPIN_CAP) { atomicAdd(&bar[XB_TMO], 1u); break; } }
    }
    nloc = mine > 0u ? mine : 1u; nx = cnt > 0u ? cnt : 1u;
}

__device__ __forceinline__ void xcd_barrier(const XcdBarrier& b, const bool thread0) {
    asm volatile("s_waitcnt vmcnt(0)" ::: "memory");
    __syncthreads();
    if (thread0) {
        unsigned* bar = b.bar;
        __builtin_amdgcn_s_waitcnt(0);
        unsigned nloc = b.st[0], nx = b.st[1];
        if (nloc == 0u) { xcd_barrier_complete(bar, b.x, nloc, nx); b.st[0] = nloc; b.st[1] = nx; }
        const unsigned old = xb_add(&bar[XB_XSUB(b.x)], 1u);
        const unsigned gen = old / nloc;
        if (old + 1u == (gen + 1u) * nloc) {
            __builtin_amdgcn_fence(__ATOMIC_RELEASE, "agent");
            asm volatile("s_waitcnt vmcnt(0)" ::: "memory");
            const unsigned og = xb_add(&bar[XB_TOP], 1u);
            const unsigned tg = og / nx;
            if (og + 1u == (tg + 1u) * nx) xb_add(&bar[XB_TOPGEN], 1u);
            else XB_SPIN(xb_ld(&bar[XB_TOPGEN]) == tg, bar);
            __builtin_amdgcn_fence(__ATOMIC_ACQUIRE, "agent");
            xb_add(&bar[XB_XGEN(b.x)], 1u);
            asm volatile("s_waitcnt vmcnt(0)" ::: "memory");
        } else {
            XB_SPIN(xb_ld(&bar[XB_XGEN(b.x)]) == gen, bar);
            __builtin_amdgcn_fence(__ATOMIC_ACQUIRE, "agent");
            asm volatile("s_waitcnt vmcnt(0)" ::: "memory");
        }
    }
    __syncthreads();
}


__device__ __forceinline__ int win_src_col(int n) {
    if (n < 2048) return n;
    if (n < 3584) return n + 8;
    if (n < 5888) return n + 16;
    if (n < 5896) return n - 5888 + 2048;
    if (n < 5904) return n - 5896 + 3592;
    return -1;
}
template <int KIND>
__device__ __forceinline__ void p0_transpose_item(const float* W, int K, int Nsrc, bf16* WT, LAS float* scr, int kb, int nb, int lane) {
    const int k0 = 64 * kb, n0 = 32 * nb;
    int sc = n0 + (lane & 31); if (KIND == 1) sc = win_src_col(sc);
#pragma unroll 8
    for (int i = 0; i < 32; ++i) { const int kk = 2 * i + (lane >> 5); scr[kk * 33 + (lane & 31)] = (sc >= 0) ? W[(size_t)(k0 + kk) * Nsrc + sc] : 0.f; }
    LDS_WAIT(); asm volatile("" ::: "memory");
    const int c = lane & 7;
#pragma unroll
    for (int j = 0; j < 4; ++j) { const int n = (lane >> 3) + 8 * j; const LAS float* s = scr + (8 * c) * 33 + n;
        u32x4 o; o.x = pk2(s[0 * 33], s[1 * 33]); o.y = pk2(s[2 * 33], s[3 * 33]); o.z = pk2(s[4 * 33], s[5 * 33]); o.w = pk2(s[6 * 33], s[7 * 33]);
        *(u32x4*)(WT + (size_t)(n0 + n) * K + k0 + 8 * c) = o; }
    LDS_WAIT(); asm volatile("" ::: "memory");
}

__device__ __forceinline__ void phase_prologue_a(LAS unsigned char* lds, const float* c_in, const float* ada_w, const float* ada_b, float* MOD,
                                                 const float* w_in, const float* w_out, const float* w_up, const float* w_down, unsigned char* ws,
                                                 int bid, int tid, int wave, int lane) {
    if (bid < 192) {
        const int L = bid / 96, rem = bid % 96, cb = rem / 16, kr = rem % 16;
        LAS float* sc = (LAS float*)lds;
        if (tid < 128) sc[tid] = silu_f(c_in[kr * 128 + tid]);
        __syncthreads();
        const int col = cb * 2048 + 4 * tid;
        const float* wp = ada_w + ((size_t)L * DM + (size_t)kr * 128) * (6 * DM) + col;
        f32x4 acc = {0.f, 0.f, 0.f, 0.f};
#pragma unroll 8
        for (int k = 0; k < 128; ++k) { const f32x4 w = *(const f32x4*)(wp + (size_t)k * (6 * DM)); acc += w * sc[k]; }
        if (kr == 0) acc += *(const f32x4*)(ada_b + (size_t)L * 6 * DM + col);
        float* mp = MOD + (size_t)L * 6 * DM + col;
        unsafeAtomicAdd(mp + 0, acc.x); unsafeAtomicAdd(mp + 1, acc.y); unsafeAtomicAdd(mp + 2, acc.z); unsafeAtomicAdd(mp + 3, acc.w);
        __syncthreads();
    }
    LAS float* scr = (LAS float*)(lds + wave * 16384);
    const int gw = (bid & 1023) * NWAVES + wave, NGW = 256 * NWAVES;
    for (int it = gw; it < 2 * 24576; it += NGW) {
        const int L = it / 24576; int r = it % 24576;
        if (r < 6144) { p0_transpose_item<1>(w_in + (size_t)L * DM * INW, DM, INW, (bf16*)(ws + WS_WIN + L * WIN_L), scr, r / 192, r % 192, lane); continue; } r -= 6144;
        if (r < 2048) { p0_transpose_item<0>(w_out + (size_t)L * DM * DM, DM, DM, (bf16*)(ws + WS_WOUT + L * WOUT_L), scr, r / 64, r % 64, lane); continue; } r -= 2048;
        if (r < 8192) { p0_transpose_item<0>(w_up + (size_t)L * DM * HIDN, DM, HIDN, (bf16*)(ws + WS_WUP + L * WUP_L), scr, r / 256, r % 256, lane); continue; } r -= 8192;
        p0_transpose_item<0>(w_down + (size_t)L * HIDN * DM, HIDN, DM, (bf16*)(ws + WS_WDN + L * WDN_L), scr, r / 64, r % 64, lane);
    }
}

template <bool HAS_Y, bool HAS_H>
__device__ __forceinline__ void rowpass(const float* xin, const float* y, const float* rowss, const float* gate, const float* npost, float* xout,
                                        const float* npre, const float* scale, const float* shift, bf16* hout, int gw, int NGW, int lane) {
    f32x4 gv[8], pv[8], sv[8];
#pragma unroll
    for (int j = 0; j < 8; ++j) { const int col = 4 * lane + 256 * j;
        if (HAS_Y) gv[j] = *(const f32x4*)(gate + col) * *(const f32x4*)(npost + col);
        if (HAS_H) { pv[j] = *(const f32x4*)(npre + col) * (*(const f32x4*)(scale + col) + 1.0f); sv[j] = *(const f32x4*)(shift + col); } }
    for (int row = gw; row < SEQ; row += NGW) {
        f32x4 v[8];
#pragma unroll
        for (int j = 0; j < 8; ++j) v[j] = *(const f32x4*)(xin + (size_t)row * DM + 4 * lane + 256 * j);
        if (HAS_Y) {
            const float rs = rsqrtf(rowss[row] * (1.0f / DM) + EPS);
#pragma unroll
            for (int j = 0; j < 8; ++j) { const f32x4 yy = *(const f32x4*)(y + (size_t)row * DM + 4 * lane + 256 * j); v[j] += gv[j] * (yy * rs); }
#pragma unroll
            for (int j = 0; j < 8; ++j) *(f32x4*)(xout + (size_t)row * DM + 4 * lane + 256 * j) = v[j];
        }
        if (HAS_H) {
            float ss = 0.f;
#pragma unroll
            for (int j = 0; j < 8; ++j) ss += (v[j].x * v[j].x + v[j].y * v[j].y) + (v[j].z * v[j].z + v[j].w * v[j].w);
            const float r2 = rsqrtf(wave_sum(ss) * (1.0f / DM) + EPS);
#pragma unroll
            for (int j = 0; j < 8; ++j) { const f32x4 hh = v[j] * r2 * pv[j] + sv[j]; u32x2 o; o.x = pk2(hh.x, hh.y); o.y = pk2(hh.z, hh.w);
                *(u32x2*)(hout + (size_t)row * DM + 4 * lane + 256 * j) = o; }
        }
    }
}

namespace pg8 {
template <int ACT> struct EpiB {
    static constexpr bool PERM = true, AFTER_DRAIN = false;
    bf16_t* O; int ldc;
    __device__ __forceinline__ void operator()(const f32x4 (&acc)[2][2][4][2], const Unit& u, int wr, int wc, int fr, int fq) const {
        const int row0 = u.pm * BM + wr * 64 + fr, col0 = u.pn * BM + wc * 32 + 8 * fq;
#pragma unroll
        for (int ai = 0; ai < 2; ++ai)
#pragma unroll
            for (int m = 0; m < 4; ++m) { bf16_t* rowp = O + (size_t)(row0 + ai * HALF + m * 16) * ldc + col0;
#pragma unroll
                for (int bj = 0; bj < 2; ++bj) { f32x4 v0 = acc[ai][bj][m][0], v1 = acc[ai][bj][m][1];
                    if (ACT == 2) { v0 = __builtin_elementwise_max(v0, (f32x4){0.f, 0.f, 0.f, 0.f}); v1 = __builtin_elementwise_max(v1, (f32x4){0.f, 0.f, 0.f, 0.f}); v0 = v0 * v0; v1 = v1 * v1; }
                    u32x4 w; w.x = ::pk2(v0[0], v0[1]); w.y = ::pk2(v0[2], v0[3]); w.z = ::pk2(v1[0], v1[1]); w.w = ::pk2(v1[2], v1[3]);
                    *(u32x4*)(rowp + bj * HALF) = w; } }
    }
};
struct EpiF32SS {
    static constexpr bool PERM = false, AFTER_DRAIN = false;
    float* O; int ldc; float* rowss;
    __device__ __forceinline__ void operator()(const f32x4 (&acc)[2][2][4][2], const Unit& u, int wr, int wc, int fr, int fq) const {
        const int col0 = u.pn * BM + wc * 32 + 4 * fq;
#pragma unroll
        for (int ai = 0; ai < 2; ++ai)
#pragma unroll
            for (int m = 0; m < 4; ++m) { const int row = u.pm * BM + ai * HALF + wr * 64 + m * 16 + fr; float s = 0.f;
#pragma unroll
                for (int bj = 0; bj < 2; ++bj)
#pragma unroll
                    for (int n = 0; n < 2; ++n) { const f32x4 v = acc[ai][bj][m][n]; *(f32x4*)(O + (size_t)row * ldc + col0 + bj * HALF + n * 16) = v;
                        s += (v[0] * v[0] + v[1] * v[1]) + (v[2] * v[2] + v[3] * v[3]); }
                s += __shfl_xor(s, 16); s += __shfl_xor(s, 32);
                if (fq == 0) unsafeAtomicAdd(rowss + row, s); }
    }
};
}

__device__ __forceinline__ void gdn_prep_unit(LAS unsigned char* lds, const bf16* PROJ, const float* conv_w, float a_log_h, float dt_bias_h, int h, int n,
                                              unsigned char* img, bf16* UT, float* gcd, int tid) {
    LAS float* qs = (LAS float*)lds;
    LAS float* ks = (LAS float*)(lds + 33792);
    LAS float* Mm = (LAS float*)(lds + 67584);
    LAS float* At = (LAS float*)(lds + 84992);
    LAS float* sm = (LAS float*)(lds + 102400);
    LAS float *beta = sm, *gc = sm + 64, *eg = sm + 128, *rq = sm + 192, *rk = sm + 256;
    const int t0 = 64 * n;
    __syncthreads();
    {
        const int c = tid & 255, half = tid >> 8, ch = c & 127, isk = c >> 7;
        const int col = (isk ? C_GK : C_GQ) + h * 128 + ch, wcol = (isk ? 512 : 0) + h * 128 + ch;
        const float w0 = conv_w[wcol], w1 = conv_w[1536 + wcol], w2 = conv_w[2 * 1536 + wcol], w3 = conv_w[3 * 1536 + wcol];
        const int tb = t0 + 32 * half - 3;
        float x[35];
#pragma unroll
        for (int j = 0; j < 35; ++j) { const int t = tb + j; x[j] = (t >= 0) ? bf2f(PROJ[(size_t)t * NPJ + col]) : 0.f; }
        LAS float* dst = (isk ? ks : qs) + (32 * half) * 132 + ch;
#pragma unroll
        for (int i = 0; i < 32; ++i) dst[i * 132] = silu_f(w0 * x[i] + w1 * x[i + 1] + w2 * x[i + 2] + w3 * x[i + 3]);
        if (tid < 64) {
            const float b = bf2f(PROJ[(size_t)(t0 + tid) * NPJ + C_GB + h]), a = bf2f(PROJ[(size_t)(t0 + tid) * NPJ + C_GA + h]);
            float g = -__expf(a_log_h) * softplus_f(a + dt_bias_h);
#pragma unroll
            for (int o = 1; o < 64; o <<= 1) { const float up = __shfl_up(g, o); if (tid >= o) g += up; }
            beta[tid] = sigmoid_f(b); gc[tid] = g; eg[tid] = __expf(g);
        }
    }
    __syncthreads();
    {
        const int row = tid >> 2, part = tid & 3; LAS const float* src = (row < 64 ? qs + row * 132 : ks + (row - 64) * 132) + 32 * part;
        float s = 0.f;
#pragma unroll
        for (int i = 0; i < 32; ++i) s += src[i] * src[i];
        s += __shfl_xor(s, 1); s += __shfl_xor(s, 2);
        if (part == 0) { if (row < 64) rq[row] = rsqrtf(s + EPS) * 0.08838834764831845f; else rk[row - 64] = rsqrtf(s + EPS); }
    }
    __syncthreads();
    {
        const int c = tid & 255, half = tid >> 8, ch = c & 127, isk = c >> 7;
        LAS float* dst = (isk ? ks : qs) + (32 * half) * 132 + ch; LAS const float* rr = (isk ? rk : rq) + 32 * half;
#pragma unroll
        for (int i = 0; i < 32; ++i) dst[i * 132] *= rr[i];
    }
    __syncthreads();
    {
        const int blk = tid & 255, bi = blk >> 4, bj = blk & 15, isq = tid >> 8;
        LAS float* dstm = isq ? At : Mm;
        if (bj > bi) {
#pragma unroll
            for (int ii = 0; ii < 4; ++ii) *(LAS f32x4*)(dstm + (4 * bi + ii) * 68 + 4 * bj) = (f32x4){0.f, 0.f, 0.f, 0.f};
        } else {
            LAS const float* ap = (isq ? qs : ks) + (4 * bi) * 132; LAS const float* bp = ks + (4 * bj) * 132;
            float acc[4][4];
#pragma unroll
            for (int ii = 0; ii < 4; ++ii)
#pragma unroll
                for (int jj = 0; jj < 4; ++jj) acc[ii][jj] = 0.f;
#pragma unroll 4
            for (int d = 0; d < 128; d += 4) {
                f32x4 a[4], b[4];
#pragma unroll
                for (int ii = 0; ii < 4; ++ii) { a[ii] = *(LAS const f32x4*)(ap + ii * 132 + d); b[ii] = *(LAS const f32x4*)(bp + ii * 132 + d); }
#pragma unroll
                for (int ii = 0; ii < 4; ++ii)
#pragma unroll
                    for (int jj = 0; jj < 4; ++jj) acc[ii][jj] += (a[ii].x * b[jj].x + a[ii].y * b[jj].y) + (a[ii].z * b[jj].z + a[ii].w * b[jj].w);
            }
#pragma unroll
            for (int ii = 0; ii < 4; ++ii) { const int i = 4 * bi + ii; f32x4 o;
#pragma unroll
                for (int jj = 0; jj < 4; ++jj) { const int j = 4 * bj + jj; const bool keep = isq ? (j <= i) : (j < i);
                    float v = 0.f; if (keep) { v = acc[ii][jj] * __expf(gc[i] - gc[j]); if (!isq) v *= beta[i]; } o[jj] = v; }
                *(LAS f32x4*)(dstm + i * 68 + 4 * bj) = o; }
        }
    }
    __syncthreads();
    if (tid < 256) {
        float x[64];
        if (tid < 128) {
            const int col = C_GV + h * 128 + tid, wcol = 1024 + h * 128 + tid;
            const float w0 = conv_w[wcol], w1 = conv_w[1536 + wcol], w2 = conv_w[2 * 1536 + wcol], w3 = conv_w[3 * 1536 + wcol];
            float p0, p1, p2;
            p0 = (t0 >= 3) ? bf2f(PROJ[(size_t)(t0 - 3) * NPJ + col]) : 0.f; p1 = (t0 >= 2) ? bf2f(PROJ[(size_t)(t0 - 2) * NPJ + col]) : 0.f; p2 = (t0 >= 1) ? bf2f(PROJ[(size_t)(t0 - 1) * NPJ + col]) : 0.f;
#pragma unroll
            for (int i = 0; i < 64; ++i) { const float cur = bf2f(PROJ[(size_t)(t0 + i) * NPJ + col]); x[i] = silu_f(w0 * p0 + w1 * p1 + w2 * p2 + w3 * cur) * beta[i]; p0 = p1; p1 = p2; p2 = cur; }
        } else {
#pragma unroll
            for (int i = 0; i < 64; ++i) x[i] = ks[i * 132 + (tid - 128)] * beta[i] * eg[i];
        }
        int vz; asm volatile("v_mov_b32 %0, 0" : "=v"(vz));
        LAS const float* Mz = Mm + vz;
#pragma unroll
        for (int i = 1; i < 64; ++i) {
            float s0 = x[i], s1 = 0.f;
#pragma unroll
            for (int j4 = 0; j4 < (i + 3) / 4; ++j4) { const f32x4 m = *(LAS const f32x4*)(Mz + i * 68 + 4 * j4);
                if (4 * j4 + 0 < i) s0 -= m.x * x[4 * j4 + 0];
                if (4 * j4 + 1 < i) s1 -= m.y * x[4 * j4 + 1];
                if (4 * j4 + 2 < i) s0 -= m.z * x[4 * j4 + 2];
                if (4 * j4 + 3 < i) s1 -= m.w * x[4 * j4 + 3]; }
            x[i] = s0 + s1;
        }
        if (tid < 128) {
#pragma unroll
            for (int i = 0; i < 8; ++i) { u32x4 w; w.x = pk2(x[8 * i], x[8 * i + 1]); w.y = pk2(x[8 * i + 2], x[8 * i + 3]); w.z = pk2(x[8 * i + 4], x[8 * i + 5]); w.w = pk2(x[8 * i + 6], x[8 * i + 7]);
                *(u32x4*)(UT + tid * 64 + 8 * i) = w; }
        } else {
            bf16* wp = (bf16*)(img + IMG_W) + permk(tid - 128);
#pragma unroll
            for (int i = 0; i < 64; ++i) wp[i * 136] = f2bf(-x[i]);
        }
    } else {
        const int t2 = tid - 256; const float gl = gc[63];
        bf16* qp = (bf16*)(img + IMG_Q); bf16* kp = (bf16*)(img + IMG_K); bf16* ap = (bf16*)(img + IMG_A);
        for (int e = t2; e < 8192; e += 256) { const int t = e >> 7, k = e & 127; qp[t * 136 + permk(k)] = f2bf(qs[t * 132 + k] * eg[t]); }
        for (int e = t2; e < 8192; e += 256) { const int t = e >> 7, d = e & 127; kp[d * 72 + permk(t)] = f2bf(ks[t * 132 + d] * __expf(gl - gc[t])); }
        for (int e = t2; e < 4096; e += 256) { const int i = e >> 6, j = e & 63; ap[i * 72 + permk(j)] = f2bf(At[i * 68 + j]); }
        if (t2 == 0) *(float*)(img + IMG_W + 256) = __expf(gl);
    }
}

__device__ __forceinline__ bf16x8 pack8(const f32x16& x, int s) {
    f32x8 t;
#pragma unroll
    for (int j = 0; j < 8; ++j) t[j] = x[8 * s + j];
    return __builtin_bit_cast(bf16x8, __builtin_convertvector(t, bfv8));
}
constexpr int OST_OFF = 2 * IMG_BYTES, OST_STRIDE = 144;
#define GS_BAR() do { asm volatile("s_waitcnt lgkmcnt(0)" ::: "memory"); __builtin_amdgcn_s_barrier(); asm volatile("" ::: "memory"); } while (0)
struct GdnCtx { const unsigned char* img_h; const bf16* ut_h; int h, wave, lane, r, hh, c0, a; };
__device__ __forceinline__ void gdn_load_u(const GdnCtx& C, int n, u32x2 (&Uu)[2][4]) {
    const bf16* ub = C.ut_h + (size_t)n * 8192 + C.c0 * 64; unsigned uv = (unsigned)(C.r * 64 + 4 * C.hh); asm volatile("" : "+v"(uv));
#pragma unroll
    for (int mt = 0; mt < 2; ++mt)
#pragma unroll
        for (int q = 0; q < 4; ++q) Uu[mt][q] = *(const u32x2*)(ub + uv + 32 * mt + 8 * q);
}
#define GF_W(mt, T, s) (*(LAS const bf16x8*)(bw + IMG_W + (32 * (mt)) * 272 + (32 * (T) + 16 * (s)) * 2))
#define GF_Q(mt, T, s) (*(LAS const bf16x8*)(bw + IMG_Q + (32 * (mt)) * 272 + (32 * (T) + 16 * (s)) * 2))
#define GF_A(mt, m2, s) (*(LAS const bf16x8*)(ba + IMG_A + (32 * (mt)) * 144 + (32 * (m2) + 16 * (s)) * 2))
#define GF_K(T, m2, s) (*(LAS const bf16x8*)(ba + IMG_K + (32 * (T)) * 144 + (32 * (m2) + 16 * (s)) * 2))
#define GMF(acc, A, B) acc = __builtin_amdgcn_mfma_f32_32x32x16_bf16(A, B, acc, 0, 0, 0)
#define GSB() __builtin_amdgcn_sched_barrier(0)
template <int V>
__device__ __forceinline__ void gdn_step_mfma(LAS unsigned char* lds, const GdnCtx& C, int n, f32x16 (&Sacc)[4], bf16x8 (&Sbf)[4][2], u32x2 (&Uu)[2][4]) {
    if (V == 2) { asm volatile("" ::: "memory"); __builtin_amdgcn_s_barrier(); GS_BAR(); return; }
    LAS const unsigned char* buf = lds + (n & 1) * IMG_BYTES;
    LAS const unsigned char* bw = buf + C.r * 272 + 16 * C.hh;
    LAS const unsigned char* ba = buf + C.r * 144 + 16 * C.hh;
    LAS unsigned char* op = lds + OST_OFF + (C.c0 + C.r) * OST_STRIDE + 8 * C.hh;
    bf16x8 P[4], Q[4];
    bf16x8 Vbf[2][2];
    f32x16 Vn[2], O;
#pragma unroll
    for (int mt = 0; mt < 2; ++mt)
#pragma unroll
        for (int q = 0; q < 4; ++q) { Vn[mt][4 * q + 0] = bflo(Uu[mt][q].x); Vn[mt][4 * q + 1] = bfhi(Uu[mt][q].x); Vn[mt][4 * q + 2] = bflo(Uu[mt][q].y); Vn[mt][4 * q + 3] = bfhi(Uu[mt][q].y); }
    if (n + 2 < 128) gdn_load_u(C, n + 2, Uu);
    P[0] = GF_W(0, 0, 0); P[1] = GF_W(1, 0, 0); P[2] = GF_W(0, 0, 1); P[3] = GF_W(1, 0, 1); GSB();
    Q[0] = GF_W(0, 1, 0); Q[1] = GF_W(1, 1, 0); Q[2] = GF_W(0, 1, 1); Q[3] = GF_W(1, 1, 1);
    GMF(Vn[0], P[0], Sbf[0][0]); GMF(Vn[1], P[1], Sbf[0][0]); GMF(Vn[0], P[2], Sbf[0][1]); GMF(Vn[1], P[3], Sbf[0][1]); GSB();
    P[0] = GF_W(0, 2, 0); P[1] = GF_W(1, 2, 0); P[2] = GF_W(0, 2, 1); P[3] = GF_W(1, 2, 1);
    GMF(Vn[0], Q[0], Sbf[1][0]); GMF(Vn[1], Q[1], Sbf[1][0]); GMF(Vn[0], Q[2], Sbf[1][1]); GMF(Vn[1], Q[3], Sbf[1][1]); GSB();
    Q[0] = GF_W(0, 3, 0); Q[1] = GF_W(1, 3, 0); Q[2] = GF_W(0, 3, 1); Q[3] = GF_W(1, 3, 1);
    GMF(Vn[0], P[0], Sbf[2][0]); GMF(Vn[1], P[1], Sbf[2][0]); GMF(Vn[0], P[2], Sbf[2][1]); GMF(Vn[1], P[3], Sbf[2][1]); GSB();
    P[0] = GF_Q(0, 0, 0); P[1] = GF_Q(0, 0, 1); P[2] = GF_Q(0, 1, 0); P[3] = GF_Q(0, 1, 1);
    GMF(Vn[0], Q[0], Sbf[3][0]); GMF(Vn[1], Q[1], Sbf[3][0]); GMF(Vn[0], Q[2], Sbf[3][1]); GMF(Vn[1], Q[3], Sbf[3][1]); GSB();
#pragma unroll
    for (int i = 0; i < 16; ++i) O[i] = 0.f;
    Q[0] = GF_Q(0, 2, 0); Q[1] = GF_Q(0, 2, 1); Q[2] = GF_Q(0, 3, 0); Q[3] = GF_Q(0, 3, 1);
    GMF(O, P[0], Sbf[0][0]); GMF(O, P[1], Sbf[0][1]); GMF(O, P[2], Sbf[1][0]); GMF(O, P[3], Sbf[1][1]);
#pragma unroll
    for (int mt = 0; mt < 2; ++mt) { Vbf[mt][0] = pack8(Vn[mt], 0); Vbf[mt][1] = pack8(Vn[mt], 1); }
    GSB();
    P[0] = GF_A(0, 0, 0); P[1] = GF_A(0, 0, 1); P[2] = GF_A(0, 1, 0); P[3] = GF_A(0, 1, 1);
    GMF(O, Q[0], Sbf[2][0]); GMF(O, Q[1], Sbf[2][1]); GMF(O, Q[2], Sbf[3][0]); GMF(O, Q[3], Sbf[3][1]); GSB();
    Q[0] = GF_Q(1, 0, 0); Q[1] = GF_Q(1, 0, 1); Q[2] = GF_Q(1, 1, 0); Q[3] = GF_Q(1, 1, 1);
    GMF(O, P[0], Vbf[0][0]); GMF(O, P[1], Vbf[0][1]); GMF(O, P[2], Vbf[1][0]); GMF(O, P[3], Vbf[1][1]); GSB();
    asm volatile("" ::: "memory"); __builtin_amdgcn_s_barrier(); asm volatile("" ::: "memory");
#pragma unroll
    for (int q = 0; q < 4; ++q) { u32x2 w; w.x = pk2(O[4 * q], O[4 * q + 1]); w.y = pk2(O[4 * q + 2], O[4 * q + 3]); *(LAS u32x2*)(op + 16 * q) = w; }
#pragma unroll
    for (int i = 0; i < 16; ++i) O[i] = 0.f;
    P[0] = GF_Q(1, 2, 0); P[1] = GF_Q(1, 2, 1); P[2] = GF_Q(1, 3, 0); P[3] = GF_Q(1, 3, 1);
    GMF(O, Q[0], Sbf[0][0]); GMF(O, Q[1], Sbf[0][1]); GMF(O, Q[2], Sbf[1][0]); GMF(O, Q[3], Sbf[1][1]); GSB();
    Q[0] = GF_A(1, 0, 0); Q[1] = GF_A(1, 0, 1); Q[2] = GF_A(1, 1, 0); Q[3] = GF_A(1, 1, 1);
    GMF(O, P[0], Sbf[2][0]); GMF(O, P[1], Sbf[2][1]); GMF(O, P[2], Sbf[3][0]); GMF(O, P[3], Sbf[3][1]); GSB();
    P[0] = GF_K(0, 0, 0); P[1] = GF_K(0, 0, 1); P[2] = GF_K(0, 1, 0); P[3] = GF_K(0, 1, 1);
    GMF(O, Q[0], Vbf[0][0]); GMF(O, Q[1], Vbf[0][1]); GMF(O, Q[2], Vbf[1][0]); GMF(O, Q[3], Vbf[1][1]); GSB();
#pragma unroll
    for (int q = 0; q < 4; ++q) { u32x2 w; w.x = pk2(O[4 * q], O[4 * q + 1]); w.y = pk2(O[4 * q + 2], O[4 * q + 3]); *(LAS u32x2*)(op + 64 + 16 * q) = w; }
    const float cd = *(LAS const float*)(buf + IMG_W + 256);
    { f32x16 acc = Sacc[0] * cd;
      Q[0] = GF_K(1, 0, 0); Q[1] = GF_K(1, 0, 1); Q[2] = GF_K(1, 1, 0); Q[3] = GF_K(1, 1, 1);
      GMF(acc, P[0], Vbf[0][0]); GMF(acc, P[1], Vbf[0][1]); GMF(acc, P[2], Vbf[1][0]); GMF(acc, P[3], Vbf[1][1]); GSB();
      Sacc[0] = acc; }
    { f32x16 acc = Sacc[1] * cd;
      P[0] = GF_K(2, 0, 0); P[1] = GF_K(2, 0, 1); P[2] = GF_K(2, 1, 0); P[3] = GF_K(2, 1, 1);
      GMF(acc, Q[0], Vbf[0][0]); GMF(acc, Q[1], Vbf[0][1]); GMF(acc, Q[2], Vbf[1][0]); GMF(acc, Q[3], Vbf[1][1]);
      Sbf[0][0] = pack8(Sacc[0], 0); Sbf[0][1] = pack8(Sacc[0], 1); GSB();
      Sacc[1] = acc; }
    { f32x16 acc = Sacc[2] * cd;
      Q[0] = GF_K(3, 0, 0); Q[1] = GF_K(3, 0, 1); Q[2] = GF_K(3, 1, 0); Q[3] = GF_K(3, 1, 1);
      GMF(acc, P[0], Vbf[0][0]); GMF(acc, P[1], Vbf[0][1]); GMF(acc, P[2], Vbf[1][0]); GMF(acc, P[3], Vbf[1][1]);
      Sbf[1][0] = pack8(Sacc[1], 0); Sbf[1][1] = pack8(Sacc[1], 1); GSB();
      Sacc[2] = acc; }
    { f32x16 acc = Sacc[3] * cd;
      GMF(acc, Q[0], Vbf[0][0]); GMF(acc, Q[1], Vbf[0][1]); GMF(acc, Q[2], Vbf[1][0]); GMF(acc, Q[3], Vbf[1][1]);
      Sbf[2][0] = pack8(Sacc[2], 0); Sbf[2][1] = pack8(Sacc[2], 1);
      Sacc[3] = acc; Sbf[3][0] = pack8(acc, 0); Sbf[3][1] = pack8(acc, 1); }
    GS_BAR();
}
constexpr int JUNK_OFF = OST_OFF + 128 * OST_STRIDE;
static_assert(JUNK_OFF + 1024 <= LDSCTL_OFF, "GDN scan LDS map");
__device__ __forceinline__ void glds16(const void* gsrc, unsigned lds_dst) {
    unsigned keep;
    asm volatile("s_mov_b32 %0, m0\n\ts_mov_b32 m0, %2\n\ts_nop 0\n\tglobal_load_lds_dwordx4 %1, off\n\ts_mov_b32 m0, %0" : "=&s"(keep) : "v"(gsrc), "s"(lds_dst) : "memory");
}
__device__ __forceinline__ void glds4(const void* gsrc, unsigned lds_dst) {
    unsigned keep;
    asm volatile("s_mov_b32 %0, m0\n\ts_mov_b32 m0, %2\n\ts_nop 0\n\tglobal_load_lds_dword %1, off\n\ts_mov_b32 m0, %0" : "=&s"(keep) : "v"(gsrc), "s"(lds_dst) : "memory");
}
__device__ __forceinline__ void gdn_touch(const GdnCtx& C, unsigned ldsbase, int m) {
    m = m < 127 ? m : 127;
    const unsigned char* src = C.img_h + (size_t)m * IMG_BYTES; const unsigned jk = __builtin_amdgcn_readfirstlane(ldsbase + (unsigned)JUNK_OFF);
    glds4(src + 128u * (unsigned)C.a, jk);
    glds4(src + 128u * (unsigned)(C.a < 232 ? C.a + 256 : C.a), jk);
}
__device__ __forceinline__ void gdn_ld_img(const GdnCtx& C, int m, u32x4 (&R)[16]) {
    m = m < 127 ? m : 127;
    const unsigned char* src = C.img_h + (size_t)m * IMG_BYTES; const int w = C.wave & 3;
    const unsigned vo = 16u * (unsigned)C.lane;
#pragma unroll
    for (int k = 0; k < 16; ++k) { const int p = 4 * k + w; const unsigned char* q = src + (p < 61 ? p * 1024 : 0);
        asm volatile("global_load_dwordx4 %0, %1, %2" : "=v"(R[k]) : "v"(vo), "s"(q) : "memory"); }
}
template <int V>
__device__ __forceinline__ void gdn_step_aux(LAS unsigned char* lds, const GdnCtx& C, int n, u32x4 (&R)[16], bf16* OT) {
    if (V == 3) { GS_BAR(); GS_BAR(); return; }
    const unsigned ldsbase = (unsigned)(size_t)lds;
    if (n < 2) asm volatile("s_waitcnt vmcnt(0)" ::: "memory"); else asm volatile("s_waitcnt vmcnt(6)" ::: "memory");
    __builtin_amdgcn_sched_barrier(0);
    if (n + 1 < 128) { LAS unsigned char* dst = lds + ((n + 1) & 1) * IMG_BYTES + 16u * (unsigned)C.lane; const int w = C.wave & 3;
#pragma unroll
        for (int k = 0; k < 16; ++k) { const int p = 4 * k + w; if (p < 61) *(LAS u32x4*)(dst + p * 1024) = R[k]; } }
    u32x4 ot[4];
    if (n >= 1) { LAS const unsigned char* op = lds + OST_OFF + (C.a >> 1) * OST_STRIDE + (C.a & 1) * 64;
#pragma unroll
        for (int i = 0; i < 4; ++i) ot[i] = *(LAS const u32x4*)(op + 16 * i); }
    GS_BAR();
    gdn_ld_img(C, n + 2, R);
    if (n >= 1) { bf16* gp = OT + (size_t)(n - 1) * 8192 + C.a * 32;
#pragma unroll
        for (int i = 0; i < 4; ++i) *(u32x4*)(gp + 8 * i) = ot[i]; }
    __builtin_amdgcn_sched_barrier(0);
    gdn_touch(C, ldsbase, n + 6);
    GS_BAR();
}
template <int V>
__device__ __forceinline__ void gdn_scan(LAS unsigned char* lds, const unsigned char* IMG, const bf16* UT, bf16* OTall, int h, int tid) {
    GdnCtx C; C.wave = __builtin_amdgcn_readfirstlane(tid >> 6); C.lane = tid & 63; C.r = C.lane & 31; C.hh = C.lane >> 5; C.c0 = 32 * (C.wave & 3); C.a = tid - 256; C.h = h;
    C.img_h = IMG + (size_t)h * 128 * IMG_BYTES; C.ut_h = UT + (size_t)h * 128 * 8192; bf16* OT = OTall + (size_t)h * 128 * 8192;
    __syncthreads();
    { unsigned off = 16u * (unsigned)tid;
#pragma unroll
      for (int k = 0; k < 8; ++k) { const unsigned o = off + 8192u * k; if (o < (unsigned)IMG_BYTES) *(LAS u32x4*)(lds + o) = *(const u32x4*)(C.img_h + o); } }
    if (C.wave < 4) {
        f32x16 Sacc[4]; bf16x8 Sbf[4][2]; u32x2 U0[2][4], U1[2][4];
#pragma unroll
        for (int T = 0; T < 4; ++T) {
#pragma unroll
            for (int i = 0; i < 16; ++i) Sacc[T][i] = 0.f;
            Sbf[T][0] = (bf16x8){0, 0, 0, 0, 0, 0, 0, 0}; Sbf[T][1] = (bf16x8){0, 0, 0, 0, 0, 0, 0, 0}; }
        gdn_load_u(C, 0, U0); gdn_load_u(C, 1, U1);
        GS_BAR();
#pragma unroll 1
        for (int n2 = 0; n2 < 64; ++n2) { gdn_step_mfma<V>(lds, C, 2 * n2, Sacc, Sbf, U0); gdn_step_mfma<V>(lds, C, 2 * n2 + 1, Sacc, Sbf, U1); }
    } else {
        const unsigned ldsbase = (unsigned)(size_t)lds;
        u32x4 R[16];
        if (V != 3) gdn_ld_img(C, 1, R);
        gdn_touch(C, ldsbase, 2); gdn_touch(C, ldsbase, 3); gdn_touch(C, ldsbase, 4); gdn_touch(C, ldsbase, 5);
        GS_BAR();
#pragma unroll 1
        for (int n = 0; n < 128; ++n) gdn_step_aux<V>(lds, C, n, R, OT);
        asm volatile("s_waitcnt vmcnt(0)" ::: "memory"); __builtin_amdgcn_sched_barrier(0);
        { LAS const unsigned char* op = lds + OST_OFF + (C.a >> 1) * OST_STRIDE + (C.a & 1) * 64; bf16* gp = OT + (size_t)127 * 8192 + C.a * 32;
#pragma unroll
          for (int i = 0; i < 4; ++i) *(u32x4*)(gp + 8 * i) = *(LAS const u32x4*)(op + 16 * i); }
    }
}

__device__ __forceinline__ void gdn_post_unit(LAS unsigned char* lds, const bf16* OT, const bf16* PROJ, const float* norm_w, bf16* YCAT, int h, int n, int tid) {
    LAS bf16* tile = (LAS bf16*)lds;
    __syncthreads();
    { const int row = tid >> 2, q = tid & 3; const u32x4 a = *(const u32x4*)(OT + row * 64 + 16 * q), b = *(const u32x4*)(OT + row * 64 + 16 * q + 8);
      *(LAS u32x4*)(tile + row * 72 + 16 * q) = a; *(LAS u32x4*)(tile + row * 72 + 16 * q + 8) = b; }
    __syncthreads();
    const int tok = tid >> 3, p8 = tid & 7; const size_t t = (size_t)(64 * n + tok);
    float o[16]; float ss = 0.f;
#pragma unroll
    for (int j = 0; j < 16; ++j) { o[j] = bf2f(tile[(16 * p8 + j) * 72 + tok]); ss += o[j] * o[j]; }
    ss += __shfl_xor(ss, 1); ss += __shfl_xor(ss, 2); ss += __shfl_xor(ss, 4);
    const float rs = rsqrtf(ss * (1.0f / 128.0f) + EPS);
    const bf16* zp = PROJ + t * NPJ + C_GZ + h * 128 + 16 * p8; bf16* yp = YCAT + t * DM + h * 128 + 16 * p8; const float* nw = norm_w + 16 * p8;
#pragma unroll
    for (int i = 0; i < 2; ++i) { const u32x4 z = *(const u32x4*)(zp + 8 * i); const f32x4 n0 = *(const f32x4*)(nw + 8 * i), n1 = *(const f32x4*)(nw + 8 * i + 4); u32x4 w;
        w.x = pk2(o[8 * i + 0] * rs * n0.x * silu_f(bflo(z.x)), o[8 * i + 1] * rs * n0.y * silu_f(bfhi(z.x)));
        w.y = pk2(o[8 * i + 2] * rs * n0.z * silu_f(bflo(z.y)), o[8 * i + 3] * rs * n0.w * silu_f(bfhi(z.y)));
        w.z = pk2(o[8 * i + 4] * rs * n1.x * silu_f(bflo(z.z)), o[8 * i + 5] * rs * n1.y * silu_f(bfhi(z.z)));
        w.w = pk2(o[8 * i + 6] * rs * n1.z * silu_f(bflo(z.w)), o[8 * i + 7] * rs * n1.w * silu_f(bfhi(z.w)));
        *(u32x4*)(yp + 8 * i) = w; }
}

__device__ __forceinline__ void ssd_step1_unit(LAS unsigned char* lds, const bf16* PROJ, const float* conv_w, const float* conv_b, float a_log_h, float dt_bias_h,
                                               int c, int h, float* SST, float* SCD, int tid) {
    LAS float* xw = (LAS float*)lds;
    LAS float* bm = (LAS float*)(lds + 34816);
    LAS float* dtv = (LAS float*)(lds + 102400);
    LAS float* dac = dtv + 128;
    LAS float* tmp = dtv + 256;
    const int g = h >> 2, t0 = 128 * c;
    __syncthreads();
    if (tid < 128) { const float d = softplus_f(bf2f(PROJ[(size_t)(t0 + tid) * NPJ + C_SDT + h]) + dt_bias_h); dtv[tid] = d; tmp[tid] = -__expf(a_log_h) * d; }
    __syncthreads();
    if (tid < 128) { float s = 0.f; for (int i = 0; i <= tid; ++i) s += tmp[i]; dac[tid] = s; }
    __syncthreads();
    {
        const int p = tid & 63, lq = tid >> 6, cch = h * 64 + p, col = C_SX + cch;
        const float w0 = conv_w[cch], w1 = conv_w[1024 + cch], w2 = conv_w[2048 + cch], w3 = conv_w[3072 + cch], bb = conv_b[cch];
        const int tb = t0 + 16 * lq - 3; float x[19];
#pragma unroll
        for (int j = 0; j < 19; ++j) { const int t = tb + j; x[j] = (t >= 0) ? bf2f(PROJ[(size_t)t * NPJ + col]) : 0.f; }
        const float dl = dac[127];
#pragma unroll
        for (int i = 0; i < 16; ++i) { const int l = 16 * lq + i; xw[l * 68 + p] = silu_f(w0 * x[i] + w1 * x[i + 1] + w2 * x[i + 2] + w3 * x[i + 3] + bb) * dtv[l] * __expf(dl - dac[l]); }
    }
    {
        const int nn = tid & 127, lq = tid >> 7, cch = 512 + g * 128 + nn, col = C_SX + cch;
        const float w0 = conv_w[cch], w1 = conv_w[1024 + cch], w2 = conv_w[2048 + cch], w3 = conv_w[3072 + cch], bb = conv_b[cch];
        const int tb = t0 + 32 * lq - 3; float x[35];
#pragma unroll
        for (int j = 0; j < 35; ++j) { const int t = tb + j; x[j] = (t >= 0) ? bf2f(PROJ[(size_t)t * NPJ + col]) : 0.f; }
#pragma unroll
        for (int i = 0; i < 32; ++i) bm[(32 * lq + i) * 132 + nn] = silu_f(w0 * x[i] + w1 * x[i + 1] + w2 * x[i + 2] + w3 * x[i + 3] + bb);
    }
    __syncthreads();
    {
        const int p0 = 4 * (tid & 15), n0 = 4 * (tid >> 4);
        float acc[4][4];
#pragma unroll
        for (int i = 0; i < 4; ++i)
#pragma unroll
            for (int j = 0; j < 4; ++j) acc[i][j] = 0.f;
#pragma unroll 4
        for (int l = 0; l < 128; ++l) { const f32x4 a = *(LAS const f32x4*)(xw + l * 68 + p0), b = *(LAS const f32x4*)(bm + l * 132 + n0);
#pragma unroll
            for (int i = 0; i < 4; ++i)
#pragma unroll
                for (int j = 0; j < 4; ++j) acc[i][j] += a[i] * b[j]; }
        float* sp = SST + ((size_t)(c * 8 + h) * 64 + p0) * 128 + n0;
#pragma unroll
        for (int i = 0; i < 4; ++i) *(f32x4*)(sp + i * 128) = (f32x4){acc[i][0], acc[i][1], acc[i][2], acc[i][3]};
        if (tid == 0) SCD[c * 8 + h] = __expf(dac[127]);
    }
}
__device__ __forceinline__ void ssd_scan(float* SST, const float* SCD, int bid, int tid) {
    if (tid < 256) {
        const int e = bid * 256 + tid, h = e >> 13; float S = 0.f;
#pragma unroll 8
        for (int c = 0; c < 64; ++c) { const float v = SST[(size_t)c * 65536 + e]; SST[(size_t)c * 65536 + e] = S; S = S * SCD[c * 8 + h] + v; }
    }
}
__device__ __forceinline__ void ssd_step3_unit(LAS unsigned char* lds, const bf16* PROJ, const float* conv_w, const float* conv_b, const float* a_log, const float* dt_bias,
                                               const float* d_skip, const float* norm_w, const float* SST, bf16* YCAT, int c, int g, int lq, int tid) {
    LAS float* cm = (LAS float*)lds;
    LAS float* bmt = (LAS float*)(lds + 16896);
    LAS float* xs = (LAS float*)(lds + 33792);
    LAS float* G = (LAS float*)(lds + 67072);
    LAS float* prv = (LAS float*)(lds + 85504);
    LAS float* dtv = (LAS float*)(lds + 122368);
    LAS float* dac = dtv + 512;
    LAS float* tmp = dtv + 1024;
    const int t0 = 128 * c, tq = t0 + 32 * lq;
    __syncthreads();
    { const int hq = tid >> 7, l = tid & 127, h = g * 4 + hq; const float d = softplus_f(bf2f(PROJ[(size_t)(t0 + l) * NPJ + C_SDT + h]) + dt_bias[h]); dtv[tid] = d; tmp[tid] = -__expf(a_log[h]) * d; }
    __syncthreads();
    { const int hq = tid >> 7, l = tid & 127; float s = 0.f; for (int i = 0; i <= l; ++i) s += tmp[hq * 128 + i]; dac[tid] = s; }
    {
        const int nn = tid & 127, q4 = tid >> 7, cch = 768 + g * 128 + nn, col = C_SX + cch;
        const float w0 = conv_w[cch], w1 = conv_w[1024 + cch], w2 = conv_w[2048 + cch], w3 = conv_w[3072 + cch], bb = conv_b[cch];
        const int tb = tq + 8 * q4 - 3; float x[11];
#pragma unroll
        for (int j = 0; j < 11; ++j) { const int t = tb + j; x[j] = (t >= 0) ? bf2f(PROJ[(size_t)t * NPJ + col]) : 0.f; }
#pragma unroll
        for (int i = 0; i < 8; ++i) cm[(8 * q4 + i) * 132 + nn] = silu_f(w0 * x[i] + w1 * x[i + 1] + w2 * x[i + 2] + w3 * x[i + 3] + bb);
    }
    const int lb = tid >> 6, cb4 = tid & 63, hq_t = cb4 >> 4;
    float y[4][4];
#pragma unroll
    for (int i = 0; i < 4; ++i)
#pragma unroll
        for (int j = 0; j < 4; ++j) y[i][j] = 0.f;
    for (int st = 0; st <= lq; ++st) {
        __syncthreads();
        const int ts = t0 + 32 * st;
        {
            const int nn = tid & 127, q4 = tid >> 7, cch = 512 + g * 128 + nn, col = C_SX + cch;
            const float w0 = conv_w[cch], w1 = conv_w[1024 + cch], w2 = conv_w[2048 + cch], w3 = conv_w[3072 + cch], bb = conv_b[cch];
            const int tb = ts + 8 * q4 - 3; float x[11];
#pragma unroll
            for (int j = 0; j < 11; ++j) { const int t = tb + j; x[j] = (t >= 0) ? bf2f(PROJ[(size_t)t * NPJ + col]) : 0.f; }
#pragma unroll
            for (int i = 0; i < 8; ++i) bmt[(8 * q4 + i) * 132 + nn] = silu_f(w0 * x[i] + w1 * x[i + 1] + w2 * x[i + 2] + w3 * x[i + 3] + bb);
        }
        {
            const int ch = tid & 255, half = tid >> 8, cch = g * 256 + ch, col = C_SX + cch;
            const float w0 = conv_w[cch], w1 = conv_w[1024 + cch], w2 = conv_w[2048 + cch], w3 = conv_w[3072 + cch], bb = conv_b[cch];
            const int tb = ts + 16 * half - 3; float x[19];
#pragma unroll
            for (int j = 0; j < 19; ++j) { const int t = tb + j; x[j] = (t >= 0) ? bf2f(PROJ[(size_t)t * NPJ + col]) : 0.f; }
#pragma unroll
            for (int i = 0; i < 16; ++i) xs[(16 * half + i) * 260 + ch] = silu_f(w0 * x[i] + w1 * x[i + 1] + w2 * x[i + 2] + w3 * x[i + 3] + bb);
        }
        __syncthreads();
        {
            const int l = tid >> 4, s0 = 2 * (tid & 15);
            float a0 = 0.f, a1 = 0.f;
#pragma unroll 4
            for (int nn = 0; nn < 128; nn += 4) { const f32x4 cv = *(LAS const f32x4*)(cm + l * 132 + nn), b0 = *(LAS const f32x4*)(bmt + s0 * 132 + nn), b1 = *(LAS const f32x4*)(bmt + (s0 + 1) * 132 + nn);
                a0 += (cv.x * b0.x + cv.y * b0.y) + (cv.z * b0.z + cv.w * b0.w); a1 += (cv.x * b1.x + cv.y * b1.y) + (cv.z * b1.z + cv.w * b1.w); }
            const int Labs = 32 * lq + l, S0 = 32 * st + s0;
#pragma unroll
            for (int hq = 0; hq < 4; ++hq) {
                const float dl = dac[hq * 128 + Labs];
                G[(hq * 32 + l) * 36 + s0] = (S0 <= Labs) ? a0 * __expf(dl - dac[hq * 128 + S0]) * dtv[hq * 128 + S0] : 0.f;
                G[(hq * 32 + l) * 36 + s0 + 1] = (S0 + 1 <= Labs) ? a1 * __expf(dl - dac[hq * 128 + S0 + 1]) * dtv[hq * 128 + S0 + 1] : 0.f;
            }
        }
        __syncthreads();
        {
            LAS const float* gp = G + (hq_t * 32 + 4 * lb) * 36;
#pragma unroll 4
            for (int s = 0; s < 32; ++s) { const f32x4 xv = *(LAS const f32x4*)(xs + s * 260 + 4 * cb4);
#pragma unroll
                for (int i = 0; i < 4; ++i) { const float w = gp[i * 36 + s];
#pragma unroll
                    for (int j = 0; j < 4; ++j) y[i][j] += w * xv[j]; } }
            if (st == lq) { const float dsk = d_skip[g * 4 + hq_t];
#pragma unroll
                for (int i = 0; i < 4; ++i) { const f32x4 xv = *(LAS const f32x4*)(xs + (4 * lb + i) * 260 + 4 * cb4);
#pragma unroll
                    for (int j = 0; j < 4; ++j) y[i][j] += dsk * xv[j]; } }
        }
    }
    float yo[4][4];
#pragma unroll
    for (int i = 0; i < 4; ++i)
#pragma unroll
        for (int j = 0; j < 4; ++j) yo[i][j] = 0.f;
    for (int nt = 0; nt < 4; ++nt) {
        __syncthreads();
        { const int ch = tid >> 1, half = tid & 1; const float* sp = SST + ((size_t)(c * 8 + g * 4 + (ch >> 6)) * 64 + (ch & 63)) * 128 + 32 * nt + 16 * half;
#pragma unroll
            for (int i = 0; i < 4; ++i) *(LAS f32x4*)(prv + ch * 36 + 16 * half + 4 * i) = *(const f32x4*)(sp + 4 * i); }
        __syncthreads();
#pragma unroll 2
        for (int nn = 0; nn < 32; nn += 4) {
            f32x4 cv[4], pv[4];
#pragma unroll
            for (int i = 0; i < 4; ++i) { cv[i] = *(LAS const f32x4*)(cm + (4 * lb + i) * 132 + 32 * nt + nn); pv[i] = *(LAS const f32x4*)(prv + (4 * cb4 + i) * 36 + nn); }
#pragma unroll
            for (int i = 0; i < 4; ++i)
#pragma unroll
                for (int j = 0; j < 4; ++j) yo[i][j] += (cv[i].x * pv[j].x + cv[i].y * pv[j].y) + (cv[i].z * pv[j].z + cv[i].w * pv[j].w);
        }
    }
    const f32x4 nw = *(const f32x4*)(norm_w + g * 256 + 4 * cb4);
#pragma unroll
    for (int i = 0; i < 4; ++i) {
        const int l = 4 * lb + i; const size_t t = (size_t)(tq + l);
        const float ed = __expf(dac[hq_t * 128 + 32 * lq + l]);
        const u32x2 z = *(const u32x2*)(PROJ + t * NPJ + C_SZ + g * 256 + 4 * cb4);
        f32x4 v;
        v.x = (y[i][0] + ed * yo[i][0]) * silu_f(bflo(z.x)); v.y = (y[i][1] + ed * yo[i][1]) * silu_f(bfhi(z.x));
        v.z = (y[i][2] + ed * yo[i][2]) * silu_f(bflo(z.y)); v.w = (y[i][3] + ed * yo[i][3]) * silu_f(bfhi(z.y));
        const float ss = wave_sum((v.x * v.x + v.y * v.y) + (v.z * v.z + v.w * v.w));
        const float rs = rsqrtf(ss * (1.0f / 256.0f) + EPS);
        u32x2 o; o.x = pk2(v.x * rs * nw.x, v.y * rs * nw.y); o.y = pk2(v.z * rs * nw.z, v.w * rs * nw.w);
        *(u32x2*)(YCAT + t * DM + 512 + g * 256 + 4 * cb4) = o;
    }
}

__device__ __forceinline__ void swa_unit(LAS unsigned char* lds, const bf16* PROJ, const f32x2* ROPE, const float* sinks, bf16* YCAT, int b, int g, int hp, int tid) {
    LAS float* Kl = (LAS float*)lds;
    LAS float* Vl = (LAS float*)(lds + 65536);
    __syncthreads();
    {
        const int key = tid >> 1, half = tid & 1; const int t = 128 * (b - 1) + key;
        LAS float* kd = Kl + key * 64; LAS float* vd = Vl + key * 64 + 32 * half;
        if (t < 0) {
#pragma unroll
            for (int i = 0; i < 16; ++i) { kd[16 * half + i] = 0.f; kd[32 + 16 * half + i] = 0.f; }
#pragma unroll
            for (int i = 0; i < 32; ++i) vd[i] = 0.f;
        } else {
            const bf16* kp = PROJ + (size_t)t * NPJ + C_AK + g * 64 + 16 * half; const bf16* vp = PROJ + (size_t)t * NPJ + C_AV + g * 64 + 32 * half;
            const f32x2* rp = ROPE + (size_t)t * 32 + 16 * half;
#pragma unroll
            for (int i = 0; i < 16; ++i) { const float k1 = bf2f(kp[i]), k2 = bf2f(kp[32 + i]); const f32x2 cs = rp[i];
                kd[16 * half + i] = k1 * cs.x - k2 * cs.y; kd[32 + 16 * half + i] = k2 * cs.x + k1 * cs.y; }
#pragma unroll
            for (int i = 0; i < 4; ++i) { const u32x4 v = *(const u32x4*)(vp + 8 * i);
                *(LAS f32x4*)(vd + 8 * i) = (f32x4){bflo(v.x), bfhi(v.x), bflo(v.y), bfhi(v.y)}; *(LAS f32x4*)(vd + 8 * i + 4) = (f32x4){bflo(v.z), bfhi(v.z), bflo(v.w), bfhi(v.w)}; }
        }
    }
    const int half = tid & 1, qi = (tid >> 1) & 127, head = g * 4 + hp * 2 + (tid >> 8); const size_t tq = (size_t)(128 * b + qi);
    float q[32];
    {
        const bf16* qp = PROJ + tq * NPJ + C_AQ + head * 64 + 32 * half; const f32x2* rp = ROPE + tq * 32;
        const float sg = half ? 0.125f : -0.125f;
#pragma unroll
        for (int i = 0; i < 32; ++i) { const float mine = bf2f(qp[i]); const float other = __shfl_xor(mine, 1); const f32x2 cs = rp[i];
            q[i] = mine * cs.x * 0.125f + other * cs.y * sg; }
    }
    __syncthreads();
    float acc[32];
#pragma unroll
    for (int i = 0; i < 32; ++i) acc[i] = 0.f;
    float mrun = sinks[head], lrun = 1.0f;
    const int i0 = qi & ~31;
    const int kmin = (b == 0) ? 128 : 0;
    for (int kg = 0; kg < 40; ++kg) {
        const int kj0 = i0 + 4 * kg;
        float s[4];
#pragma unroll
        for (int u = 0; u < 4; ++u) { LAS const float* kr = Kl + (kj0 + u) * 64 + 32 * half; float d0 = 0.f, d1 = 0.f;
#pragma unroll
            for (int d = 0; d < 32; d += 4) { const f32x4 kv = *(LAS const f32x4*)(kr + d); d0 += q[d] * kv.x + q[d + 2] * kv.z; d1 += q[d + 1] * kv.y + q[d + 3] * kv.w; }
            s[u] = d0 + d1; }
#pragma unroll
        for (int u = 0; u < 4; ++u) { s[u] += __shfl_xor(s[u], 1); const int kj = kj0 + u, rel = qi + 128 - kj; if (!(rel >= 0 && rel < 128 && kj >= kmin)) s[u] = -INFINITY; }
        const float mnew = fmaxf(fmaxf(fmaxf(s[0], s[1]), fmaxf(s[2], s[3])), mrun);
        const float alpha = __expf(mrun - mnew);
        float p[4];
#pragma unroll
        for (int u = 0; u < 4; ++u) p[u] = __expf(s[u] - mnew);
        lrun = lrun * alpha + (p[0] + p[1]) + (p[2] + p[3]); mrun = mnew;
#pragma unroll
        for (int i = 0; i < 32; ++i) acc[i] *= alpha;
#pragma unroll
        for (int u = 0; u < 4; ++u) { LAS const float* vr = Vl + (kj0 + u) * 64 + 32 * half;
#pragma unroll
            for (int d = 0; d < 32; d += 4) { const f32x4 vv = *(LAS const f32x4*)(vr + d); acc[d] += p[u] * vv.x; acc[d + 1] += p[u] * vv.y; acc[d + 2] += p[u] * vv.z; acc[d + 3] += p[u] * vv.w; } }
        asm volatile("" ::: "memory");
    }
    const float inv = 1.0f / lrun;
    bf16* yp = YCAT + tq * DM + 1024 + head * 64 + 32 * half;
#pragma unroll
    for (int i = 0; i < 4; ++i) { u32x4 w; w.x = pk2(acc[8 * i] * inv, acc[8 * i + 1] * inv); w.y = pk2(acc[8 * i + 2] * inv, acc[8 * i + 3] * inv);
        w.z = pk2(acc[8 * i + 4] * inv, acc[8 * i + 5] * inv); w.w = pk2(acc[8 * i + 6] * inv, acc[8 * i + 7] * inv); *(u32x4*)(yp + 8 * i) = w; }
}

__device__ __forceinline__ void sc_unit(const bf16* PROJ, const float* conv_w, bf16* YCAT, int rb, int tid) {
    const int c = tid, t0 = 32 * rb;
    const float w0 = conv_w[c], w1 = conv_w[512 + c], w2 = conv_w[1024 + c];
    float p0 = 0.f, p1 = 0.f;
    if (t0 >= 2) p0 = bf2f(PROJ[(size_t)(t0 - 2) * NPJ + C_CC + c]) * bf2f(PROJ[(size_t)(t0 - 2) * NPJ + C_CH + c]);
    if (t0 >= 1) p1 = bf2f(PROJ[(size_t)(t0 - 1) * NPJ + C_CC + c]) * bf2f(PROJ[(size_t)(t0 - 1) * NPJ + C_CH + c]);
#pragma unroll 8
    for (int i = 0; i < 32; ++i) { const size_t t = (size_t)(t0 + i);
        const float p2 = bf2f(PROJ[t * NPJ + C_CC + c]) * bf2f(PROJ[t * NPJ + C_CH + c]);
        YCAT[t * DM + 1536 + c] = f2bf(bf2f(PROJ[t * NPJ + C_CB + c]) * (w0 * p0 + w1 * p1 + w2 * p2)); p0 = p1; p1 = p2; }
}

__device__ __forceinline__ int lane_now() { int l; asm volatile("v_mbcnt_lo_u32_b32 %0, -1, 0\n\tv_mbcnt_hi_u32_b32 %0, -1, %0" : "=v"(l)); return l; }
struct Args { const void* in[25]; float* out; unsigned char* ws; int ph_lo, ph_hi; };
__global__ void __launch_bounds__(NWAVES * 64, 2) mk_fwd(Args args) {
    extern __shared__ __attribute__((aligned(16))) unsigned char lds_raw[];
    LAS unsigned char* lds = (LAS unsigned char*)lds_raw;
    volatile LAS unsigned* MISC = (volatile LAS unsigned*)(lds + MISC_OFF);
    const int wave0 = __builtin_amdgcn_readfirstlane((int)threadIdx.x >> 6);
#define TID_NOW() (wave0 * 64 + lane_now())
    const int tid = TID_NOW(), lane = tid & 63, wave = wave0, bid = blockIdx.x, G = gridDim.x;
    unsigned char* ws = args.ws;
    unsigned* ctl = (unsigned*)(ws + WS_CTL);
    for (int u = tid; u < (LDS_BYTES - LDSCTL_OFF) / 4; u += NWAVES * 64) ((LAS unsigned*)(lds + LDSCTL_OFF))[u] = 0u;
    __syncthreads();
    XcdBarrier bar; bar.bar = ctl + CW_BAR; bar.x = 0; bar.st = nullptr;
    if (!MK_SPLIT) bar = xcd_barrier_post(ctl + CW_BAR, MISC + 8, tid == 0);
#define GRID_BAR() do { if (!MK_SPLIT) xcd_barrier(bar, tid == 0); } while (0)
    const int lo = args.ph_lo, hi = args.ph_hi;
#define IN(k) (lo <= (k) && (k) < hi)
#define SEAM(k) do { if (IN(k) && IN((k) + 1)) GRID_BAR(); } while (0)
    const float* x_in = (const float*)args.in[0]; const float* c_in = (const float*)args.in[1]; const int* positions = (const int*)args.in[2];
    const float* ada_w = (const float*)args.in[3]; const float* ada_b = (const float*)args.in[4];
    const float* n_pre_mix = (const float*)args.in[5]; const float* n_post_mix = (const float*)args.in[6]; const float* n_pre_mlp = (const float*)args.in[7]; const float* n_post_mlp = (const float*)args.in[8];
    const float* w_in = (const float*)args.in[9]; const float* w_out = (const float*)args.in[10];
    const float* gdn_conv_w = (const float*)args.in[11]; const float* gdn_a_log = (const float*)args.in[12]; const float* gdn_dt_bias = (const float*)args.in[13]; const float* gdn_norm_w = (const float*)args.in[14];
    const float* ssm_conv_w = (const float*)args.in[15]; const float* ssm_conv_b = (const float*)args.in[16]; const float* ssm_a_log = (const float*)args.in[17]; const float* ssm_dt_bias = (const float*)args.in[18];
    const float* ssm_d = (const float*)args.in[19]; const float* ssm_norm_w = (const float*)args.in[20]; const float* attn_sinks = (const float*)args.in[21]; const float* sc_conv_w = (const float*)args.in[22];
    const float* w_up = (const float*)args.in[23]; const float* w_down = (const float*)args.in[24];
    float* X = args.out;
    float* MOD = (float*)(ctl + CW_MOD); float* RSS = (float*)(ctl + CW_RSS);
    bf16* Hb = (bf16*)(ws + WS_H); bf16* PROJ = (bf16*)(ws + WS_PROJ); bf16* YCAT = (bf16*)(ws + WS_YCAT); float* Y = (float*)(ws + WS_Y); bf16* HID = (bf16*)(ws + WS_HID);
    unsigned char* GIMG = ws + WS_GIMG; bf16* GUT = (bf16*)(ws + WS_GU); bf16* GOT = (bf16*)(ws + WS_GO); float* SST = (float*)(ws + WS_SST);
    float* SCD = (float*)(ws + WS_MISC); float* GCD = SCD + 512; f32x2* ROPE = (f32x2*)(ws + WS_ROPE);
    const int gw = bid * NWAVES + wave, NGW = G * NWAVES;

    if (EN(0) && IN(0)) for (int rep = 0; rep < REPS(0); ++rep) phase_prologue_a(lds, c_in, ada_w, ada_b, MOD, w_in, w_out, w_up, w_down, ws, rep == 0 ? bid : bid + 1024, tid, wave, lane);
    SEAM(0);
    if (EN(1) && IN(1)) {
        rowpass<false, true>(x_in, nullptr, nullptr, nullptr, nullptr, nullptr, n_pre_mix, MOD + 1 * DM, MOD + 0 * DM, Hb, gw, NGW, lane);
        for (int e = bid * 512 + tid; e < SEQ * 32; e += G * 512) { const float ang = (float)positions[e >> 5] * exp2f(-(float)(e & 31) * 0.4152410118609203f); float sn, cs; sincosf(ang, &sn, &cs); ROPE[e] = (f32x2){cs, sn}; }
    }
    SEAM(1);
#pragma unroll 1
    for (int L = 0; L < DEPTH; ++L) {
        const int pb = 2 + 10 * L;
        int tid = TID_NOW(); asm volatile("" : "+v"(tid));
        const int lane = tid & 63, wave = wave0, gw = bid * NWAVES + wave;
        const float* mod = MOD + (size_t)L * 6 * DM;
        if (EN(2) && IN(pb + 0)) for (int rep = 0; rep < REPS(2); ++rep) { if (rep) GRID_BAR(); pg8::Gemm g{Hb, (const bf16*)(ws + WS_WIN + L * WIN_L), SEQ, NPJ, DM}; pg8::StaticOrder S; S.init(SEQ, NPJ, G, bid);
            pg8::EpiB<0> E{PROJ, NPJ}; pg8::gemm_phase<pg8::EpiB<0>, pg8::StaticOrder, PG8_ALIGN, PG8_SP2>(lds, g, S, E, tid); }
        SEAM(pb + 0);
        if (IN(pb + 1)) for (int rep = 0; rep < REPS(3); ++rep) { if (rep) GRID_BAR();
            if (EN(3)) for (int u = bid; u < 512; u += G) { const int h = u >> 7, n = u & 127;
                gdn_prep_unit(lds, PROJ, gdn_conv_w + (size_t)L * 4 * 1536, gdn_a_log[L * 4 + h], gdn_dt_bias[L * 4 + h], h, n, GIMG + (size_t)u * IMG_BYTES, GUT + (size_t)u * 8192, GCD + u, tid); }
            if (EN(4)) for (int u = bid; u < 512; u += G) { const int c = u >> 3, h = u & 7;
                ssd_step1_unit(lds, PROJ, ssm_conv_w + (size_t)L * 4 * 1024, ssm_conv_b + (size_t)L * 1024, ssm_a_log[L * 8 + h], ssm_dt_bias[L * 8 + h], c, h, SST, SCD, tid); }
        }
        SEAM(pb + 1);
        if (EN(5) && IN(pb + 2)) ssd_scan(SST, SCD, bid, tid);
        SEAM(pb + 2);
        if (IN(pb + 3)) {
            if (bid < 4) { if (EN(6)) { gdn_scan<0>(lds, GIMG, GUT, GOT, bid, tid);
#if MK_GHOST
                gdn_scan<MK_GHOST>(lds, GIMG, GUT, (bf16*)(ws + WS_END), bid, tid);
#endif
            } }
            else for (int rep = 0; rep < REPS(7); ++rep) for (int u = bid - 4; u < 1024; u += G - 4) {
                int tid_u = tid; asm volatile("" : "+v"(tid_u));
                if (u < 256) { if (EN(7)) swa_unit(lds, PROJ, ROPE, attn_sinks + L * 8, YCAT, u >> 2, (u >> 1) & 1, u & 1, tid_u); }
                else if (u < 768) { const int v = u - 256; if (EN(8)) ssd_step3_unit(lds, PROJ, ssm_conv_w + (size_t)L * 4 * 1024, ssm_conv_b + (size_t)L * 1024, ssm_a_log + L * 8, ssm_dt_bias + L * 8,
                                                                      ssm_d + L * 8, ssm_norm_w + (size_t)L * 512, SST, YCAT, v >> 3, (v >> 2) & 1, 3 - (v & 3), tid_u); }
                else if (EN(9)) sc_unit(PROJ, sc_conv_w + (size_t)L * 3 * 512, YCAT, u - 768, tid_u);
            }
        }
        SEAM(pb + 3);
        if (IN(pb + 4)) for (int u = bid; u < 512; u += G) gdn_post_unit(lds, GOT + (size_t)u * 8192, PROJ, gdn_norm_w + (size_t)L * 128, YCAT, u >> 7, u & 127, tid);
        SEAM(pb + 4);
        if (EN(10) && IN(pb + 5)) for (int rep = 0; rep < REPS(10); ++rep) { if (rep) GRID_BAR(); pg8::Gemm g{YCAT, (const bf16*)(ws + WS_WOUT + L * WOUT_L), SEQ, DM, DM}; pg8::StaticOrder S; S.init(SEQ, DM, G, bid);
            pg8::EpiF32SS E{Y, DM, rep ? (float*)(ws + WS_END) : RSS + (2 * L) * SEQ}; pg8::gemm_phase<pg8::EpiF32SS, pg8::StaticOrder, false, PG8_SP2>(lds, g, S, E, tid); }
        SEAM(pb + 5);
        if (EN(11) && IN(pb + 6)) for (int rep = 0; rep < (L == 0 ? REPS(11) : 1); ++rep) rowpass<true, true>(L == 0 ? x_in : X, Y, RSS + (2 * L) * SEQ, mod + 2 * DM, n_post_mix + L * DM, X, n_pre_mlp + L * DM, mod + 4 * DM, mod + 3 * DM, Hb, gw, NGW, lane);
        SEAM(pb + 6);
        if (EN(12) && IN(pb + 7)) for (int rep = 0; rep < REPS(12); ++rep) { if (rep) GRID_BAR(); pg8::Gemm g{Hb, (const bf16*)(ws + WS_WUP + L * WUP_L), SEQ, HIDN, DM}; pg8::StaticOrder S; S.init(SEQ, HIDN, G, bid);
            pg8::EpiB<2> E{HID, HIDN}; pg8::gemm_phase<pg8::EpiB<2>, pg8::StaticOrder, PG8_ALIGN, PG8_SP2>(lds, g, S, E, tid); }
        SEAM(pb + 7);
        if (EN(13) && IN(pb + 8)) for (int rep = 0; rep < REPS(13); ++rep) { if (rep) GRID_BAR(); pg8::Gemm g{HID, (const bf16*)(ws + WS_WDN + L * WDN_L), SEQ, DM, HIDN}; pg8::StaticOrder S; S.init(SEQ, DM, G, bid);
            pg8::EpiF32SS E{Y, DM, rep ? (float*)(ws + WS_END) : RSS + (2 * L + 1) * SEQ}; pg8::gemm_phase<pg8::EpiF32SS, pg8::StaticOrder, false, PG8_SP2>(lds, g, S, E, tid); }
        SEAM(pb + 8);
        if (EN(14) && IN(pb + 9)) {
            if (L + 1 < DEPTH) rowpass<true, true>(X, Y, RSS + (2 * L + 1) * SEQ, mod + 5 * DM, n_post_mlp + L * DM, X, n_pre_mix + (L + 1) * DM, mod + 6 * DM + 1 * DM, mod + 6 * DM + 0 * DM, Hb, gw, NGW, lane);
            else rowpass<true, false>(X, Y, RSS + (2 * L + 1) * SEQ, mod + 5 * DM, n_post_mlp + L * DM, X, nullptr, nullptr, nullptr, nullptr, gw, NGW, lane);
        }
        if (L + 1 < DEPTH) SEAM(pb + 9);
    }
#undef IN
#undef SEAM
#undef GRID_BAR
}

extern "C" void kernel_launch(void* const* d_in, const int* in_sizes, int n_in, void* d_out, int out_size, void* d_ws, size_t ws_size, hipStream_t stream) {
    static int grid = 0;
    if (grid == 0) {
        if (n_in != 25 || out_size != SEQ * DM || ws_size < WS_END) { fprintf(stderr, "kernel_launch: unexpected shapes (n_in %d out %d ws %zu); nothing launched\n", n_in, out_size, ws_size); grid = -1; return; }
        int dev = 0, cus = 0, per_cu = 0;
        if (hipGetDevice(&dev) != hipSuccess || hipDeviceGetAttribute(&cus, hipDeviceAttributeMultiprocessorCount, dev) != hipSuccess) { grid = -1; return; }
        if (hipFuncSetAttribute((const void*)mk_fwd, hipFuncAttributeMaxDynamicSharedMemorySize, LDS_BYTES) != hipSuccess) { fprintf(stderr, "kernel_launch: hipFuncSetAttribute failed\n"); grid = -1; return; }
        if (hipOccupancyMaxActiveBlocksPerMultiprocessor(&per_cu, (const void*)mk_fwd, NWAVES * 64, LDS_BYTES) != hipSuccess || per_cu < 1)
            fprintf(stderr, "kernel_launch: note: occupancy query reports %d workgroups per CU\n", per_cu);
        (void)hipGetLastError();
        grid = cus;
        if (grid != 256) { fprintf(stderr, "kernel_launch: built for 256 CUs, device has %d; nothing launched\n", cus); grid = -1; return; }
    }
    if (grid < 0) return;
    if (hipMemsetAsync((char*)d_ws + WS_CTL, 0, CTL_ZERO_BYTES, stream) != hipSuccess) return;
    Args a{};
    for (int i = 0; i < 25; ++i) a.in[i] = d_in[i];
    a.out = (float*)d_out; a.ws = (unsigned char*)d_ws;
#if MK_SPLIT
    for (int p = 0; p < NPHASES; ++p) { a.ph_lo = p; a.ph_hi = p + 1; hipLaunchKernelGGL(mk_fwd, dim3(grid), dim3(NWAVES * 64), LDS_BYTES, stream, a); }
#else
    a.ph_lo = 0; a.ph_hi = NPHASES;
    hipLaunchKernelGGL(mk_fwd, dim3(grid), dim3(NWAVES * 64), LDS_BYTES, stream, a);
#endif
}
```
